# Optimizing an MI355X kernel written in HIP

```python
import jax
import jax.numpy as jnp
from jax import lax
import numpy as np

D_MODEL = 2048
BATCH = 2
SEQ = 4096
DEPTH = 2
DEC_BATCH = 16
DEC_SEQ = 32
PAST_LEN = 1024

CHUNK = 64
ATT_HEADS = 8
KV_HEADS = 2
HEAD_DIM = 128
IDX_HEADS = 16
IDX_DIM = 64
TOPK_MAX = 256
Q_BLOCK = 128
ROPE_THETA = 10000.0
SSD_HEADS = 16
SSD_HEADDIM = 64
SSD_GROUPS = 2
SSD_STATE = 128
SSD_INNER = SSD_HEADS * SSD_HEADDIM
SSD_CONV_DIM = SSD_INNER + 2 * SSD_GROUPS * SSD_STATE
CONV_W = 4
LRU_WIDTH = D_MODEL
LRU_BLOCKS = 16
LRU_BLOCK_DIM = LRU_WIDTH // LRU_BLOCKS
LRU_C = 8.0
FFN_DIM = ((8 * D_MODEL + 2) // 3 + 255) // 256 * 256
ATT_WIDTH = ATT_HEADS * HEAD_DIM
AB_SIZES = (ATT_WIDTH, KV_HEADS * HEAD_DIM, KV_HEADS * HEAD_DIM, IDX_HEADS * IDX_DIM, IDX_DIM, IDX_HEADS, SSD_INNER, SSD_CONV_DIM, SSD_HEADS)
AB_IN_DIM = sum(AB_SIZES)
MIX_WIDTH = ATT_WIDTH + SSD_INNER
N_ATT_LAYERS = (DEPTH + 1) // 2
N_LRU_LAYERS = DEPTH // 2
EPS = 1e-6

kernel_name = 'hybrid_dsa_ssd_rglru_stream_step'


def rmsnorm(x, w):
    xf = x.astype(jnp.float32)
    y = xf * lax.rsqrt(jnp.mean(xf * xf, axis=-1, keepdims=True) + EPS)
    return (y * w.astype(jnp.float32)).astype(x.dtype)


def rope(x, pos):
    half = x.shape[-1] // 2
    inv = jnp.power(ROPE_THETA, -jnp.arange(half, dtype=jnp.float32) / half)
    ang = pos.astype(jnp.float32)[:, None] * inv[None, :]
    cos = jnp.cos(ang)[:, None, :]
    sin = jnp.sin(ang)[:, None, :]
    xf = x.astype(jnp.float32)
    x1, x2 = xf[..., :half], xf[..., half:]
    return jnp.concatenate([x1 * cos - x2 * sin, x1 * sin + x2 * cos], axis=-1).astype(x.dtype)


def causal_dwconv(u, buf, w, b):
    t = u.shape[1]
    full = jnp.concatenate([buf.astype(u.dtype), u], axis=1)
    out = b
    for j in range(CONV_W):
        out = out + full[:, j:j + t] * w[j]
    return out, full[:, t:]


def lin_combine(e1, e2):
    a1, b1 = e1
    a2, b2 = e2
    return a1 * a2, a2 * b1 + b2


def swiglu(h, wg, wu, wd):
    return (jax.nn.silu(h @ wg) * (h @ wu)) @ wd


def dsa_attention(q, qi, wi, k, v, ki, q_pos, topk):
    b_, t = q.shape[:2]
    n_keys = k.shape[1]
    qb = Q_BLOCK if t % Q_BLOCK == 0 else t
    nb = t // qb
    k_chunk = jnp.arange(n_keys) // CHUNK

    def blocks(u):
        return jnp.moveaxis(u.reshape((b_, nb, qb) + u.shape[2:]), 1, 0)

    def one_block(args):
        q_b, qi_b, wi_b, pos_b = args
        q_chunk = pos_b // CHUNK
        s_idx = jnp.einsum('bqhd,bkd->bqhk', qi_b, ki) * IDX_DIM ** -0.5
        score = jnp.einsum('bqh,bqhk->bqk', wi_b, jax.nn.relu(s_idx)).astype(jnp.float32)
        score = jnp.where(k_chunk[None, None, :] <= q_chunk[None, :, None], score, -jnp.inf)
        _, sel = lax.top_k(score, topk)
        valid = (sel // CHUNK) <= q_chunk[None, :, None]
        kg = jax.vmap(lambda kb, ib: kb[ib])(k, sel)
        vg = jax.vmap(lambda vb, ib: vb[ib])(v, sel)
        qg = q_b.reshape(b_, qb, KV_HEADS, ATT_HEADS // KV_HEADS, HEAD_DIM)
        s = jnp.einsum('bqgrd,bqkgd->bqgrk', qg, kg).astype(jnp.float32) * HEAD_DIM ** -0.5
        s = jnp.where(valid[:, :, None, None, :], s, -jnp.inf)
        p = jax.nn.softmax(s, axis=-1).astype(v.dtype)
        o = jnp.einsum('bqgrk,bqkgd->bqgrd', p, vg)
        return o.reshape(b_, qb, ATT_WIDTH)

    out = lax.map(one_block, (blocks(q), blocks(qi), blocks(wi), q_pos.reshape(nb, qb)))
    return jnp.moveaxis(out, 0, 1).reshape(b_, t, ATT_WIDTH)


def ssd_scan(xh, dt, a_neg, bm, cm, h0):
    b_, t = xh.shape[:2]
    cl = min(CHUNK, t)
    nc = t // cl
    tri = jnp.tril(jnp.ones((cl, cl), dtype=bool))

    def to_chunks(u):
        return jnp.moveaxis(u.reshape((b_, nc, cl) + u.shape[2:]), 1, 0)

    def step(h, inp):
        x_c, dt_c, b_c, c_c = inp
        cum = jnp.cumsum(dt_c * a_neg, axis=1)
        seg = cum[:, :, None] - cum[:, None, :]
        decay = jnp.exp(jnp.where(tri[None, :, :, None, None], seg, -jnp.inf))
        cb = jnp.einsum('btgn,bsgn->btsg', c_c, b_c)
        wts = cb[..., None] * decay * dt_c[:, None]
        y = jnp.einsum('btsgh,bsghp->btghp', wts, x_c)
        y = y + jnp.einsum('btgn,bghpn->btghp', c_c, h) * jnp.exp(cum)[..., None]
        tail = jnp.exp(cum[:, -1:] - cum) * dt_c
        h_new = h * jnp.exp(cum[:, -1])[..., None, None] + jnp.einsum('bsgh,bsgn,bsghp->bghpn', tail, b_c, x_c)
        return h_new, y

    h_fin, ys = lax.scan(step, h0, (to_chunks(xh), to_chunks(dt), to_chunks(bm), to_chunks(cm)))
    y = jnp.moveaxis(ys, 0, 1).reshape(xh.shape)
    return y, h_fin


def mixer_ab(h, past_k, past_v, past_ki, ssm_h0, conv_buf, w_in, q_norm_w, k_norm_w,
             conv_w, conv_b, dt_bias, a_log, d_skip, norm_w, w_out):
    b_, t, _ = h.shape
    past = past_k.shape[1]
    proj = h @ w_in
    q, k, v, qi, ki, wi, z, xbc, dt_raw = jnp.split(proj, np.cumsum(AB_SIZES)[:-1].tolist(), axis=-1)
    q_pos = past + jnp.arange(t)
    q = rope(rmsnorm(q.reshape(b_, t, ATT_HEADS, HEAD_DIM), q_norm_w), q_pos)
    k = rope(rmsnorm(k.reshape(b_, t, KV_HEADS, HEAD_DIM), k_norm_w), q_pos)
    v = v.reshape(b_, t, KV_HEADS, HEAD_DIM)
    qi = rope(qi.reshape(b_, t, IDX_HEADS, IDX_DIM), q_pos)
    ki = rope(ki[:, :, None], q_pos)[:, :, 0]
    wi = wi * IDX_HEADS ** -0.5
    k_all = jnp.concatenate([past_k.astype(k.dtype), k], axis=1)
    v_all = jnp.concatenate([past_v.astype(v.dtype), v], axis=1)
    ki_all = jnp.concatenate([past_ki.astype(ki.dtype), ki], axis=1)
    topk = min(TOPK_MAX, (past + t) // 4)
    att = dsa_attention(q, qi, wi, k_all, v_all, ki_all, q_pos, topk)
    xbc, conv_new = causal_dwconv(xbc, conv_buf, conv_w, conv_b)
    xbc = jax.nn.silu(xbc)
    xs, bm, cm = jnp.split(xbc, [SSD_INNER, SSD_INNER + SSD_GROUPS * SSD_STATE], axis=-1)
    hg = SSD_HEADS // SSD_GROUPS
    xs_h = xs.reshape(b_, t, SSD_GROUPS, hg, SSD_HEADDIM).astype(jnp.float32)
    dt = jax.nn.softplus(dt_raw.astype(jnp.float32) + dt_bias.astype(jnp.float32)).reshape(b_, t, SSD_GROUPS, hg)
    a_neg = -jnp.exp(a_log.astype(jnp.float32)).reshape(SSD_GROUPS, hg)
    y, h_new = ssd_scan(xs_h, dt, a_neg,
                        bm.reshape(b_, t, SSD_GROUPS, SSD_STATE).astype(jnp.float32),
                        cm.reshape(b_, t, SSD_GROUPS, SSD_STATE).astype(jnp.float32),
                        ssm_h0.reshape(b_, SSD_GROUPS, hg, SSD_HEADDIM, SSD_STATE).astype(jnp.float32))
    y = y + d_skip.astype(jnp.float32).reshape(SSD_GROUPS, hg)[..., None] * xs_h
    y = y.reshape(b_, t, SSD_GROUPS, hg * SSD_HEADDIM).astype(h.dtype)
    y = y * jax.nn.silu(z.reshape(b_, t, SSD_GROUPS, hg * SSD_HEADDIM))
    y = rmsnorm(y, norm_w.reshape(SSD_GROUPS, hg * SSD_HEADDIM)).reshape(b_, t, SSD_INNER)
    out = jnp.concatenate([att, y], axis=-1) @ w_out
    h_new = h_new.reshape(b_, SSD_HEADS, SSD_HEADDIM, SSD_STATE).astype(ssm_h0.dtype)
    return out, k, v, ki, h_new, conv_new


def mixer_c(h, h0, conv_buf, w_in, conv_w, conv_b, w_a, b_a, w_x, b_x, lam, w_out):
    b_, t, _ = h.shape
    gate_in, x_in = jnp.split(h @ w_in, 2, axis=-1)
    xc, conv_new = causal_dwconv(x_in, conv_buf, conv_w, conv_b)
    xb = xc.reshape(b_, t, LRU_BLOCKS, LRU_BLOCK_DIM)
    r = jax.nn.sigmoid((jnp.einsum('btkd,kde->btke', xb, w_a).reshape(b_, t, LRU_WIDTH) + b_a).astype(jnp.float32))
    i = jax.nn.sigmoid((jnp.einsum('btkd,kde->btke', xb, w_x).reshape(b_, t, LRU_WIDTH) + b_x).astype(jnp.float32))
    log_a = -LRU_C * r * jax.nn.softplus(-lam.astype(jnp.float32))
    a = jnp.exp(log_a)
    u = jnp.sqrt(-jnp.expm1(2.0 * log_a)) * (i * xc.astype(jnp.float32))
    a_cum, u_cum = lax.associative_scan(lin_combine, (a, u), axis=1)
    hs = a_cum * h0.astype(jnp.float32)[:, None] + u_cum
    y = hs.astype(h.dtype) * jax.nn.gelu(gate_in)
    return y @ w_out, hs[:, -1].astype(h0.dtype), conv_new


def trunk(x, c, att_k, att_v, idx_k, ssm_h, ssm_conv, lru_h, lru_conv, p):
    k_l, v_l, ki_l, ssm_l, ssmc_l, lru_l, lruc_l = [], [], [], [], [], [], []
    for l in range(DEPTH):
        j = l // 2
        mod = jax.nn.silu(c) @ p['ada_w'][l] + p['ada_b'][l]
        sh_m, sc_m, g_m, sh_f, sc_f, g_f = jnp.split(mod, 6, axis=-1)
        h = rmsnorm(x, p['norm_mix_w'][l]) * (1.0 + sc_m[:, None]) + sh_m[:, None]
        if l % 2 == 0:
            mix, k, v, ki, hs, cs = mixer_ab(
                h, att_k[j], att_v[j], idx_k[j], ssm_h[j], ssm_conv[j],
                p['w_in_ab'][j], p['q_norm_w'][j], p['k_norm_w'][j], p['ssd_conv_w'][j], p['ssd_conv_b'][j],
                p['ssd_dt_bias'][j], p['ssd_a_log'][j], p['ssd_d'][j], p['ssd_norm_w'][j], p['w_out_ab'][j])
            k_l.append(k)
            v_l.append(v)
            ki_l.append(ki)
            ssm_l.append(hs)
            ssmc_l.append(cs)
        else:
            mix, hl, cl = mixer_c(
                h, lru_h[j], lru_conv[j], p['w_in_c'][j], p['lru_conv_w'][j], p['lru_conv_b'][j],
                p['lru_w_a'][j], p['lru_b_a'][j], p['lru_w_x'][j], p['lru_b_x'][j], p['lru_lambda'][j], p['w_out_c'][j])
            lru_l.append(hl)
            lruc_l.append(cl)
        x = x + g_m[:, None] * mix
        h = rmsnorm(x, p['norm_ffn_w'][l]) * (1.0 + sc_f[:, None]) + sh_f[:, None]
        x = x + g_f[:, None] * swiglu(h, p['ffn_w_gate'][l], p['ffn_w_up'][l], p['ffn_w_down'][l])
    return (x, jnp.stack(k_l), jnp.stack(v_l), jnp.stack(ki_l), jnp.stack(ssm_l), jnp.stack(ssmc_l),
            jnp.stack(lru_l), jnp.stack(lruc_l))


def setup_inputs(seed: int = 0) -> dict:
    key = jax.random.key(seed)
    keys = list(jax.random.split(key, 48))

    def nrm(shape, scale):
        return jax.random.normal(keys.pop(), shape, jnp.float32) * scale

    def unif(shape, lo, hi):
        return jax.random.uniform(keys.pop(), shape, jnp.float32, lo, hi)

    na, nl, d = N_ATT_LAYERS, N_LRU_LAYERS, D_MODEL
    dt0 = jnp.exp(unif((na, SSD_HEADS), float(np.log(1e-3)), float(np.log(1e-1))))
    s0 = unif((nl, LRU_WIDTH), 0.9, 0.999) ** (1.0 / LRU_C)
    return {
        'x_prompt': nrm((BATCH, SEQ, d), 1.0),
        'x_sample': nrm((DEC_BATCH, DEC_SEQ, d), 1.0),
        'cache_attn_k': nrm((na, DEC_BATCH, PAST_LEN, KV_HEADS, HEAD_DIM), 1.0),
        'cache_attn_v': nrm((na, DEC_BATCH, PAST_LEN, KV_HEADS, HEAD_DIM), 1.0),
        'cache_idx_k': nrm((na, DEC_BATCH, PAST_LEN, IDX_DIM), 1.0),
        'state_ssm': nrm((na, DEC_BATCH, SSD_HEADS, SSD_HEADDIM, SSD_STATE), 0.1),
        'state_ssm_conv': nrm((na, DEC_BATCH, CONV_W - 1, SSD_CONV_DIM), 1.0),
        'state_lru': nrm((nl, DEC_BATCH, LRU_WIDTH), 0.5),
        'state_lru_conv': nrm((nl, DEC_BATCH, CONV_W - 1, LRU_WIDTH), 1.0),
        'c_prompt': nrm((BATCH, d), 1.0),
        'c_sample': nrm((DEC_BATCH, d), 1.0),
        'ada_w': nrm((DEPTH, d, 6 * d), 0.5 * d ** -0.5),
        'ada_b': nrm((DEPTH, 6 * d), 0.02),
        'norm_mix_w': 1.0 + nrm((DEPTH, d), 0.02),
        'norm_ffn_w': 1.0 + nrm((DEPTH, d), 0.02),
        'w_in_ab': nrm((na, d, AB_IN_DIM), d ** -0.5),
        'q_norm_w': 1.0 + nrm((na, HEAD_DIM), 0.02),
        'k_norm_w': 1.0 + nrm((na, HEAD_DIM), 0.02),
        'ssd_conv_w': nrm((na, CONV_W, SSD_CONV_DIM), CONV_W ** -0.5),
        'ssd_conv_b': nrm((na, SSD_CONV_DIM), 0.02),
        'ssd_dt_bias': dt0 + jnp.log(-jnp.expm1(-dt0)),
        'ssd_a_log': jnp.log(unif((na, SSD_HEADS), 1.0, 16.0)),
        'ssd_d': 1.0 + nrm((na, SSD_HEADS), 0.02),
        'ssd_norm_w': 1.0 + nrm((na, SSD_INNER), 0.02),
        'w_out_ab': nrm((na, MIX_WIDTH, d), MIX_WIDTH ** -0.5),
        'w_in_c': nrm((nl, d, 2 * LRU_WIDTH), d ** -0.5),
        'lru_conv_w': nrm((nl, CONV_W, LRU_WIDTH), CONV_W ** -0.5),
        'lru_conv_b': nrm((nl, LRU_WIDTH), 0.02),
        'lru_w_a': nrm((nl, LRU_BLOCKS, LRU_BLOCK_DIM, LRU_BLOCK_DIM), LRU_BLOCK_DIM ** -0.5),
        'lru_b_a': nrm((nl, LRU_WIDTH), 0.02),
        'lru_w_x': nrm((nl, LRU_BLOCKS, LRU_BLOCK_DIM, LRU_BLOCK_DIM), LRU_BLOCK_DIM ** -0.5),
        'lru_b_x': nrm((nl, LRU_WIDTH), 0.02),
        'lru_lambda': jnp.log(s0) - jnp.log1p(-s0),
        'w_out_c': nrm((nl, LRU_WIDTH, d), LRU_WIDTH ** -0.5),
        'ffn_w_gate': nrm((DEPTH, d, FFN_DIM), d ** -0.5),
        'ffn_w_up': nrm((DEPTH, d, FFN_DIM), d ** -0.5),
        'ffn_w_down': nrm((DEPTH, FFN_DIM, d), FFN_DIM ** -0.5),
    }


def reference(x_prompt, x_sample, cache_attn_k, cache_attn_v, cache_idx_k, state_ssm, state_ssm_conv,
              state_lru, state_lru_conv, c_prompt, c_sample, ada_w, ada_b, norm_mix_w, norm_ffn_w,
              w_in_ab, q_norm_w, k_norm_w, ssd_conv_w, ssd_conv_b, ssd_dt_bias, ssd_a_log, ssd_d, ssd_norm_w,
              w_out_ab, w_in_c, lru_conv_w, lru_conv_b, lru_w_a, lru_b_a, lru_w_x, lru_b_x, lru_lambda, w_out_c,
              ffn_w_gate, ffn_w_up, ffn_w_down):
    p = dict(ada_w=ada_w, ada_b=ada_b, norm_mix_w=norm_mix_w, norm_ffn_w=norm_ffn_w,
             w_in_ab=w_in_ab, q_norm_w=q_norm_w, k_norm_w=k_norm_w, ssd_conv_w=ssd_conv_w, ssd_conv_b=ssd_conv_b,
             ssd_dt_bias=ssd_dt_bias, ssd_a_log=ssd_a_log, ssd_d=ssd_d, ssd_norm_w=ssd_norm_w, w_out_ab=w_out_ab,
             w_in_c=w_in_c, lru_conv_w=lru_conv_w, lru_conv_b=lru_conv_b, lru_w_a=lru_w_a, lru_b_a=lru_b_a,
             lru_w_x=lru_w_x, lru_b_x=lru_b_x, lru_lambda=lru_lambda, w_out_c=w_out_c,
             ffn_w_gate=ffn_w_gate, ffn_w_up=ffn_w_up, ffn_w_down=ffn_w_down)
    bp = x_prompt.shape[0]
    empty_k = jnp.zeros((N_ATT_LAYERS, bp, 0, KV_HEADS, HEAD_DIM), cache_attn_k.dtype)
    empty_v = jnp.zeros((N_ATT_LAYERS, bp, 0, KV_HEADS, HEAD_DIM), cache_attn_v.dtype)
    empty_ki = jnp.zeros((N_ATT_LAYERS, bp, 0, IDX_DIM), cache_idx_k.dtype)
    zero_ssm = jnp.zeros((N_ATT_LAYERS, bp) + state_ssm.shape[2:], state_ssm.dtype)
    zero_ssm_conv = jnp.zeros((N_ATT_LAYERS, bp) + state_ssm_conv.shape[2:], state_ssm_conv.dtype)
    zero_lru = jnp.zeros((N_LRU_LAYERS, bp) + state_lru.shape[2:], state_lru.dtype)
    zero_lru_conv = jnp.zeros((N_LRU_LAYERS, bp) + state_lru_conv.shape[2:], state_lru_conv.dtype)
    y_prompt, k_p, v_p, ki_p, ssm_p, ssmc_p, lru_p, lruc_p = trunk(
        x_prompt, c_prompt, empty_k, empty_v, empty_ki, zero_ssm, zero_ssm_conv, zero_lru, zero_lru_conv, p)
    y_sample, k_s, v_s, ki_s, ssm_s, ssmc_s, lru_s, lruc_s = trunk(
        x_sample, c_sample, cache_attn_k, cache_attn_v, cache_idx_k, state_ssm, state_ssm_conv,
        state_lru, state_lru_conv, p)
    return (y_prompt, y_sample, k_p, v_p, ki_p, ssm_p, ssmc_p, lru_p, lruc_p,
            k_s, v_s, ki_s, ssm_s, ssmc_s, lru_s, lruc_s)
```

```cpp
#include <hip/hip_runtime.h>
#include <hip/hip_cooperative_groups.h>
#include <cstdio>
#include <cstdint>
namespace cg = cooperative_groups;

typedef unsigned short u16;
typedef __attribute__((ext_vector_type(8))) short bf16x8;
typedef __attribute__((ext_vector_type(16))) float f32x16;
typedef __attribute__((ext_vector_type(4))) unsigned u32x4;

#ifndef MULTI_LAUNCH
#define MULTI_LAUNCH 0
#endif

#ifndef DUP_MASK
#define DUP_MASK 0
#endif
#define HALF_LDS 67584
#define FOR_ITEMS(total, it) for (int _hb = tidx_opaque() >> 8, _j = blockIdx.x, it = 2 * _j + _hb; 2 * _j < (total); _j += gridDim.x, it = 2 * _j + _hb)
constexpr int NTOK = 8704;
constexpr int ABN = 5216;
constexpr int FFN = 5632;
constexpr int NPHASE = 22;
constexpr int O_KP = 17825792, O_VP = 19922944, O_KIP = 22020096, O_SSMP = 22544384, O_SSMCP = 22806528,
              O_LRUP = 22815744, O_LRUCP = 22819840, O_KS = 22832128, O_VS = 22963200, O_KIS = 23094272,
              O_SSMS = 23127040, O_SSMCS = 25224192, O_LRUS = 25297920, O_LRUCS = 25330688;

struct Params {
  const float *x_prompt, *x_sample, *cache_k, *cache_v, *cache_ki, *state_ssm, *state_ssm_conv, *state_lru,
      *state_lru_conv, *c_prompt, *c_sample;
  const float *ada_w, *ada_b, *norm_mix_w, *norm_ffn_w, *w_in_ab, *q_norm_w, *k_norm_w, *ssd_conv_w, *ssd_conv_b,
      *ssd_dt_bias, *ssd_a_log, *ssd_d, *ssd_norm_w, *w_out_ab, *w_in_c, *lru_conv_w, *lru_conv_b, *lru_w_a,
      *lru_b_a, *lru_w_x, *lru_b_x, *lru_lambda, *w_out_c, *ffn_w_gate, *ffn_w_up, *ffn_w_down;
  float* out;
  u16 *Wt_in_ab, *Wt_out_ab, *Wt_gu, *Wt_down, *Wt_in_c, *Wt_ax, *Wt_out_c;
  float* mod;
  float* modp;
  u16* Abuf;
  float* R1;
  float* R2;
  float* xcur;
  u16 *qb, *qib;
  float* wi;
  u16 *Kb, *Vb, *kib;
  float *xs, *bm, *cm, *dt, *cumb;
  int* sel;
  float *aggA, *aggU;
  unsigned* bar;
};

typedef const __attribute__((address_space(4))) Params* cparams_t;
__device__ __forceinline__ const Params& opaque_params(const Params& p0) {
  cparams_t q = (cparams_t)__builtin_amdgcn_kernarg_segment_ptr();
  asm volatile("" : "+s"(q));
  return *(const Params*)q;
}
__device__ __forceinline__ int tidx_opaque() {
  int t = threadIdx.x;
  asm volatile("" : "+v"(t));
  return t;
}
__device__ __forceinline__ u16 f2bf(float f) {
  unsigned u = __float_as_uint(f);
  u += 0x7fffu + ((u >> 16) & 1u);
  return (u16)(u >> 16);
}
__device__ __forceinline__ unsigned pack2(float a, float b) { return (unsigned)f2bf(a) | ((unsigned)f2bf(b) << 16); }
__device__ __forceinline__ float bf2f(u16 h) { return __uint_as_float((unsigned)h << 16); }
__device__ __forceinline__ float bflo(unsigned u) { return __uint_as_float(u << 16); }
__device__ __forceinline__ float bfhi(unsigned u) { return __uint_as_float(u & 0xffff0000u); }
__device__ __forceinline__ float wave_sum(float v) {
#pragma unroll
  for (int o = 32; o > 0; o >>= 1) v += __shfl_xor(v, o);
  return v;
}
__device__ __forceinline__ float wave_max(float v) {
#pragma unroll
  for (int o = 32; o > 0; o >>= 1) v = fmaxf(v, __shfl_xor(v, o));
  return v;
}
__device__ __forceinline__ float siluf_(float x) { return x / (1.f + __expf(-x)); }
__device__ __forceinline__ void tok_info(int tok, int& seq, int& t, int& pos, int& T) {
  if (tok < 8192) { seq = tok >> 12; t = tok & 4095; pos = t; T = 4096; }
  else { int r = tok - 8192; seq = 2 + (r >> 5); t = r & 31; pos = 1024 + t; T = 32; }
}
__device__ __forceinline__ int tok_seq(int tok) { return tok < 8192 ? (tok >> 12) : 2 + ((tok - 8192) >> 5); }
__device__ __forceinline__ int kv_base(int seq) { return seq < 2 ? seq * 4096 : 8192 + (seq - 2) * 1056; }
__device__ __forceinline__ const float* xin_row(const Params& p, int tok) {
  return tok < 8192 ? p.x_prompt + (size_t)tok * 2048 : p.x_sample + (size_t)(tok - 8192) * 2048;
}
__device__ __forceinline__ void rope_cs(float fpos, int i, float inv_half, float& c, float& s) {
  float inv = exp2f(-(float)i * inv_half * 13.287712379549449f);
  float ang = fpos * inv;
  float rev = ang * 0.15915494309189535f;
  rev -= floorf(rev);
  c = __builtin_amdgcn_cosf(rev);
  s = __builtin_amdgcn_sinf(rev);
}
__device__ __forceinline__ f32x16 zero16() {
  f32x16 z;
#pragma unroll
  for (int i = 0; i < 16; ++i) z[i] = 0.f;
  return z;
}

__device__ __forceinline__ void ada_item(const Params& p, int item, float* sm) {
  const int kc = item & 3, rest = item >> 2;
  const int l = rest / 192, slab = rest % 192;
  const int tid = (tidx_opaque() & 255), cl = tid & 15, kg = tid >> 4;
  float acc[18][4];
#pragma unroll
  for (int s = 0; s < 18; ++s) { acc[s][0] = acc[s][1] = acc[s][2] = acc[s][3] = 0.f; }
  const float* W = p.ada_w + (size_t)l * 2048 * 12288 + (size_t)(kc * 512) * 12288 + slab * 64 + cl * 4;
  for (int i = tid; i < 18 * 512; i += 256) {
    int s = i >> 9, k = i & 511;
    float c = s < 2 ? p.c_prompt[s * 2048 + kc * 512 + k] : p.c_sample[(s - 2) * 2048 + kc * 512 + k];
    sm[i] = c / (1.f + expf(-c));
  }
  __syncthreads();
#pragma unroll 8
  for (int kk = kg; kk < 512; kk += 16) {
    float4 w = *(const float4*)(W + (size_t)kk * 12288);
#pragma unroll
    for (int s = 0; s < 18; ++s) {
      float c = sm[s * 512 + kk];
      acc[s][0] += c * w.x; acc[s][1] += c * w.y; acc[s][2] += c * w.z; acc[s][3] += c * w.w;
    }
  }
#pragma unroll
  for (int s = 0; s < 18; ++s)
#pragma unroll
    for (int j = 0; j < 4; ++j) {
      float v = acc[s][j];
      v += __shfl_xor(v, 16);
      v += __shfl_xor(v, 32);
      acc[s][j] = v;
    }
  __syncthreads();
  const int wave = tid >> 6, lane = tid & 63;
  if (lane < 16) {
#pragma unroll
    for (int s = 0; s < 18; ++s)
#pragma unroll
      for (int j = 0; j < 4; ++j) sm[(wave * 72 + s * 4 + j) * 16 + lane] = acc[s][j];
  }
  __syncthreads();
  for (int i = tid; i < 1152; i += 256) {
    int sj = i >> 4, c = i & 15;
    float v = sm[(0 * 72 + sj) * 16 + c] + sm[(1 * 72 + sj) * 16 + c] + sm[(2 * 72 + sj) * 16 + c] + sm[(3 * 72 + sj) * 16 + c];
    int s = sj >> 2, j = sj & 3;
    int col = slab * 64 + c * 4 + j;
    p.modp[(size_t)((kc * 2 + l) * 18 + s) * 12288 + col] = v;
  }
  __syncthreads();
}

__device__ __forceinline__ void conv_tile(const float* src, int ldn, int K, int Nvalid, int Nstore, int kt, int nt, u16* dst, int mode, float* sm) {
  const int tid = (tidx_opaque() & 255);
  float4 v[16];
#pragma unroll
  for (int i = 0; i < 16; ++i) {
    int idx = tid + 256 * i;
    int kk = idx >> 6, c4 = idx & 63;
    int n = nt * 256 + c4 * 4;
    v[i] = make_float4(0.f, 0.f, 0.f, 0.f);
    if (n < Nvalid) v[i] = *(const float4*)(src + (size_t)(kt * 64 + kk) * ldn + n);
  }
#pragma unroll
  for (int i = 0; i < 16; ++i) {
    int idx = tid + 256 * i;
    int kk = idx >> 6, c4 = idx & 63;
    float* d = sm + kk * 257 + c4 * 4;
    d[0] = v[i].x; d[1] = v[i].y; d[2] = v[i].z; d[3] = v[i].w;
  }
  __syncthreads();
#pragma unroll
  for (int i = 0; i < 8; ++i) {
    int idx = tid + 256 * i;
    int nn = idx >> 3, kc = idx & 7;
    const float* s = sm + (kc * 8) * 257 + nn;
    uint4 o;
    o.x = pack2(s[0 * 257], s[1 * 257]);
    o.y = pack2(s[2 * 257], s[3 * 257]);
    o.z = pack2(s[4 * 257], s[5 * 257]);
    o.w = pack2(s[6 * 257], s[7 * 257]);
    int n = nt * 256 + nn;
    int r = (mode == 0) ? n : (64 * (n >> 5) + (n & 31) + (mode == 2 ? 32 : 0));
    if (n < Nstore) *(uint4*)(dst + (size_t)r * K + kt * 64 + kc * 8) = o;
  }
  __syncthreads();
}

__device__ __forceinline__ void conv_item(const Params& p, int i, float* sm) {
  if (i < 672) { conv_tile(p.w_in_ab, 5216, 2048, 5216, 5376, i / 21, i % 21, p.Wt_in_ab, 0, sm); return; }
  i -= 672;
  if (i < 256) { conv_tile(p.w_out_ab, 2048, 2048, 2048, 2048, i >> 3, i & 7, p.Wt_out_ab, 0, sm); return; }
  i -= 256;
  if (i < 1408) { int l = i / 704, r = i % 704;
    conv_tile(p.ffn_w_gate + (size_t)l * 2048 * 5632, 5632, 2048, 5632, 5632, r / 22, r % 22, p.Wt_gu + (size_t)l * 11264 * 2048, 1, sm); return; }
  i -= 1408;
  if (i < 1408) { int l = i / 704, r = i % 704;
    conv_tile(p.ffn_w_up + (size_t)l * 2048 * 5632, 5632, 2048, 5632, 5632, r / 22, r % 22, p.Wt_gu + (size_t)l * 11264 * 2048, 2, sm); return; }
  i -= 1408;
  if (i < 1408) { int l = i / 704, r = i % 704;
    conv_tile(p.ffn_w_down + (size_t)l * 5632 * 2048, 2048, 5632, 2048, 2048, r >> 3, r & 7, p.Wt_down + (size_t)l * 2048 * 5632, 0, sm); return; }
  i -= 1408;
  if (i < 512) { conv_tile(p.w_in_c, 4096, 2048, 4096, 4096, i >> 4, i & 15, p.Wt_in_c, 0, sm); return; }
  i -= 512;
  if (i < 256) { conv_tile(p.w_out_c, 2048, 2048, 2048, 2048, i >> 3, i & 7, p.Wt_out_c, 0, sm); return; }
  i -= 256;
  if (i < 32) { int kb = i >> 1, kt = i & 1;
    conv_tile(p.lru_w_a + kb * 16384, 128, 128, 128, 128, kt, 0, p.Wt_ax + kb * 32768, 1, sm); return; }
  i -= 32;
  { int kb = i >> 1, kt = i & 1;
    conv_tile(p.lru_w_x + kb * 16384, 128, 128, 128, 128, kt, 0, p.Wt_ax + kb * 32768, 2, sm); }
}

__device__ __forceinline__ void cache_item(const Params& p, int i) {
  const int tid = (tidx_opaque() & 255);
  const float* src; u16* dst; int rowlen;
  if (i < 2048) { src = p.cache_k; dst = p.Kb; rowlen = 256; }
  else if (i < 4096) { i -= 2048; src = p.cache_v; dst = p.Vb; rowlen = 256; }
  else { i -= 4096; src = p.cache_ki; dst = p.kib; rowlen = 64; }
  int e = i * 2048 + tid * 8;
  int row = e / rowlen, col = e % rowlen;
  int b = row >> 10, pos = row & 1023;
  float4 v0 = *(const float4*)(src + e), v1 = *(const float4*)(src + e + 4);
  uint4 o;
  o.x = pack2(v0.x, v0.y); o.y = pack2(v0.z, v0.w); o.z = pack2(v1.x, v1.y); o.w = pack2(v1.z, v1.w);
  *(uint4*)(dst + (size_t)(8192 + b * 1056 + pos) * rowlen + col) = o;
}

__device__ __forceinline__ float4 ld4sum(const float* base, size_t stride, const float* bias) {
  float4 a = *(const float4*)base, b = *(const float4*)(base + stride), c = *(const float4*)(base + 2 * stride),
         d = *(const float4*)(base + 3 * stride), e = *(const float4*)bias;
  return make_float4(a.x + b.x + c.x + d.x + e.x, a.y + b.y + c.y + d.y + e.y, a.z + b.z + c.z + d.z + e.z, a.w + b.w + c.w + d.w + e.w);
}
template <bool PARTIAL>
__device__ __forceinline__ void phase_normmod(const Params& p, const float* xsrc, const float* nw, const float* modl, int sh_off, int sc_off) {
  const int lane = (tidx_opaque() & 255) & 63, wave = (tidx_opaque() & 255) >> 6;
  FOR_ITEMS(NTOK / 4 + (PARTIAL ? 432 : 0), it) {
    if (PARTIAL && it >= NTOK / 4) {
      int e = ((it - NTOK / 4) * 256 + (tidx_opaque() & 255)) * 4;
      int col = e % 12288, l = e / (18 * 12288);
      *(float4*)(p.mod + e) = ld4sum(p.modp + e, (size_t)2 * 18 * 12288, p.ada_b + l * 12288 + col);
      continue;
    }
    int tok = it * 4 + wave;
    const float* xr = xsrc ? xsrc + (size_t)tok * 2048 : xin_row(p, tok);
    const float* md = modl + (size_t)tok_seq(tok) * 12288;
    float4 v[8], wv[8], scv[8], shv[8];
    float ss = 0.f;
#pragma unroll
    for (int i = 0; i < 8; ++i) v[i] = *(const float4*)(xr + i * 256 + lane * 4);
#pragma unroll
    for (int i = 0; i < 8; ++i) {
      int c = i * 256 + lane * 4;
      wv[i] = *(const float4*)(nw + c);
      if (PARTIAL) {
        scv[i] = ld4sum(md + sc_off + c, (size_t)2 * 18 * 12288, p.ada_b + sc_off + c);
        shv[i] = ld4sum(md + sh_off + c, (size_t)2 * 18 * 12288, p.ada_b + sh_off + c);
      } else {
        scv[i] = *(const float4*)(md + sc_off + c);
        shv[i] = *(const float4*)(md + sh_off + c);
      }
    }
#pragma unroll
    for (int i = 0; i < 8; ++i) ss += v[i].x * v[i].x + v[i].y * v[i].y + v[i].z * v[i].z + v[i].w * v[i].w;
    ss = wave_sum(ss);
    float rn = rsqrtf(ss * (1.f / 2048.f) + 1e-6f);
#pragma unroll
    for (int i = 0; i < 8; ++i) {
      int c = i * 256 + lane * 4;
      const float4 w = wv[i], sc = scv[i], sh = shv[i];
      float a0 = v[i].x * rn * w.x * (1.f + sc.x) + sh.x;
      float a1 = v[i].y * rn * w.y * (1.f + sc.y) + sh.y;
      float a2 = v[i].z * rn * w.z * (1.f + sc.z) + sh.z;
      float a3 = v[i].w * rn * w.w * (1.f + sc.w) + sh.w;
      uint2 o; o.x = pack2(a0, a1); o.y = pack2(a2, a3);
      *(uint2*)(p.Abuf + (size_t)tok * 2048 + c) = o;
    }
  }
}

enum { EPI_F32 = 0, EPI_RESID = 1, EPI_SWIGLU = 2, EPI_LRU = 3 };
struct GemmArgs {
  const u16* A; int lda; const u16* B; int K; int ntn; int ntiles;
  float* C; int ldc; int nvalid;
  const float* xin; float* xout; const float* gate;
  u16* H;
};
typedef __attribute__((ext_vector_type(4))) float f32x4;
__device__ __forceinline__ int lds_byte(int r, int c) {
  int st = (r >> 4) * 2 + (c >> 5), ob = (r & 15) * 64 + (c & 31) * 2;
  return st * 1024 + (ob ^ (((ob >> 9) & 1) << 5));
}
__device__ __forceinline__ void stage_rc(int b, int& R, int& C) {
  int st = b >> 10, sb = b & 1023, swz = sb ^ (((sb >> 9) & 1) << 5);
  R = (st >> 1) * 16 + swz / 64;
  C = (st & 1) * 32 + (swz % 64) / 2;
}
#define WAIT_V0() asm volatile("s_waitcnt vmcnt(0)" ::: "memory")
typedef const __attribute__((address_space(1))) unsigned* gptr_t;
typedef __attribute__((address_space(3))) unsigned* lptr_t;

template <int EPI, int CFG>
__device__ __forceinline__ void gemm_phase(const Params& p, const GemmArgs& g, char* smem) {
  constexpr int WC = (CFG == 1) ? 2 : 4;
  constexpr int NF = 4;
  constexpr int MF = (CFG == 0) ? 8 : (CFG == 1 ? 4 : 9);
  constexpr int BM = (CFG == 2) ? 272 : 256;
  constexpr int BN = WC * NF * 16;
  constexpr int NSUBA = BM / 16 * 2;
  constexpr int OFF_B = NSUBA * 1024;
  constexpr int STAGE_B = OFF_B + 32768;
  constexpr int GLA = (NSUBA + 7) / 8;
  constexpr int GLB = BN * 128 / 8192;
  constexpr int WROWS = (CFG == 2) ? 144 : MF * 16;
  constexpr int ntm = (CFG == 2) ? 32 : 34;
  const int tid = tidx_opaque(), wid = tid >> 6, lane = tid & 63, wr = wid / WC, wc = wid % WC, fr = lane & 15, fq = lane >> 4;
  const bool mlast = (CFG != 2) || (wr == 0);
  int sR[GLA], sC[GLA];
#pragma unroll
  for (int i = 0; i < GLA; ++i) stage_rc(wid * 1024 + i * 8192 + lane * 16, sR[i], sC[i]);
  const int nk = g.K >> 6;
  const int G = gridDim.x;
  const int bperm = (blockIdx.x & 7) * (G >> 3) + (blockIdx.x >> 3);
#define TILE_COORDS(lin_, mt_, nt_, Ab_, Bb_)                                                                         \
  do {                                                                                                                \
    if (EPI == EPI_LRU) {                                                                                             \
      mt_ = (lin_) >> 5; nt_ = (lin_) & 31;                                                                           \
      Ab_ = g.A + (size_t)mt_ * 256 * g.lda + (nt_ >> 1) * 128;                                                       \
      Bb_ = g.B + (size_t)nt_ * 128 * 128;                                                                            \
    } else {                                                                                                          \
      const int nig_ = 8 * g.ntn, gid_ = (lin_) / nig_, fm_ = gid_ * 8, gsz_ = min(ntm - fm_, 8), rem_ = (lin_) - gid_ * nig_; \
      mt_ = fm_ + rem_ % gsz_; nt_ = rem_ / gsz_;                                                                     \
      Ab_ = g.A + (size_t)mt_ * BM * g.lda;                                                                           \
      Bb_ = g.B + (size_t)nt_ * BN * g.K;                                                                             \
    }                                                                                                                 \
  } while (0)
#define GLDS_STAGE_P(buf, kt, Ap_, Bp_)                                                                              \
  do {                                                                                                                \
    _Pragma("unroll") for (int i = 0; i < GLA; ++i)                                                                   \
        if (i * 8 + 7 < NSUBA || wid + i * 8 < NSUBA)                                                                 \
          __builtin_amdgcn_global_load_lds((gptr_t)((Ap_) + (size_t)sR[i] * g.lda + (kt) * 64 + sC[i]),               \
                                           (lptr_t)(smem + (buf) * STAGE_B + wid * 1024 + i * 8192), 16, 0, 0);        \
    _Pragma("unroll") for (int i = 0; i < GLB; ++i)                                                                   \
        __builtin_amdgcn_global_load_lds((gptr_t)((Bp_) + (size_t)sR[i] * g.K + (kt) * 64 + sC[i]),                   \
                                         (lptr_t)(smem + (buf) * STAGE_B + OFF_B + wid * 1024 + i * 8192), 16, 0, 0);  \
  } while (0)
#define GLDS_STAGE(buf, kt) GLDS_STAGE_P(buf, kt, Ab, Bb)
  constexpr bool SEAM = true;
  int mt = 0, nt = 0;
  const u16 *Ab = g.A, *Bb = g.B;
  if (bperm < g.ntiles) { TILE_COORDS(bperm, mt, nt, Ab, Bb); if (SEAM) GLDS_STAGE(0, 0); }
  for (int base = 0; base < g.ntiles; base += G) {
    const int lin = base + bperm;
    if (lin >= g.ntiles) continue;
    const int brow = mt * BM, bcol = nt * BN;
    f32x4 acc[MF][NF];
#pragma unroll
    for (int m = 0; m < MF; ++m)
#pragma unroll
      for (int n = 0; n < NF; ++n) { acc[m][n][0] = 0.f; acc[m][n][1] = 0.f; acc[m][n][2] = 0.f; acc[m][n][3] = 0.f; }
    if (!SEAM) GLDS_STAGE(0, 0);
    WAIT_V0();
    __syncthreads();
#pragma unroll 1
    for (int t = 0; t < nk; ++t) {
      const int cur = t & 1;
      if (t + 1 < nk) GLDS_STAGE(cur ^ 1, t + 1);
      const char* sa = smem + cur * STAGE_B;
      const char* sb = sa + OFF_B;
#pragma unroll
      for (int ks = 0; ks < 2; ++ks) {
        bf16x8 Bf[NF];
#pragma unroll
        for (int n = 0; n < NF; ++n) Bf[n] = *(const bf16x8*)(sb + lds_byte(wc * (NF * 16) + n * 16 + fr, ks * 32 + fq * 8));
        __builtin_amdgcn_s_setprio(1);
        if (CFG == 2) {
#pragma unroll
          for (int mb = 0; mb < 9; mb += 3) {
            bf16x8 At[3];
#pragma unroll
            for (int m = 0; m < 3; ++m)
              if (mb + m < 8 || mlast) At[m] = *(const bf16x8*)(sa + lds_byte(wr * WROWS + (mb + m) * 16 + fr, ks * 32 + fq * 8));
#pragma unroll
            for (int m = 0; m < 3; ++m)
              if (mb + m < 8 || mlast) {
#pragma unroll
                for (int n = 0; n < NF; ++n) acc[mb + m][n] = __builtin_amdgcn_mfma_f32_16x16x32_bf16(At[m], Bf[n], acc[mb + m][n], 0, 0, 0);
              }
          }
        } else {
          bf16x8 At[MF];
#pragma unroll
          for (int m = 0; m < MF; ++m) At[m] = *(const bf16x8*)(sa + lds_byte(wr * WROWS + m * 16 + fr, ks * 32 + fq * 8));
#pragma unroll
          for (int m = 0; m < MF; ++m)
#pragma unroll
            for (int n = 0; n < NF; ++n) acc[m][n] = __builtin_amdgcn_mfma_f32_16x16x32_bf16(At[m], Bf[n], acc[m][n], 0, 0, 0);
        }
        __builtin_amdgcn_s_setprio(0);
      }
      WAIT_V0();
      __syncthreads();
    }
    const int nt_cur = nt, mt_cur = mt;
    {
      const int nlin = lin + G;
      if (nlin < g.ntiles) { TILE_COORDS(nlin, mt, nt, Ab, Bb); if (SEAM) GLDS_STAGE(0, 0); }
    }
    const int rb = brow + wr * WROWS + fq * 4;
    const int cb = bcol + wc * (NF * 16) + fr;
    if (EPI == EPI_F32) {
#pragma unroll
      for (int n = 0; n < NF; ++n) {
        int col = cb + n * 16;
        if (col < g.nvalid) {
#pragma unroll
          for (int m = 0; m < MF; ++m)
            if (m < 8 || mlast) {
#pragma unroll
              for (int j = 0; j < 4; ++j) g.C[(size_t)(rb + m * 16 + j) * g.ldc + col] = acc[m][n][j];
            }
        }
      }
    } else if (EPI == EPI_RESID) {
#pragma unroll
      for (int m = 0; m < MF; ++m)
        if (m < 8 || mlast) {
          float xv[4][NF], gv[4][NF];
#pragma unroll
          for (int j = 0; j < 4; ++j) {
            int row = rb + m * 16 + j;
            const float* __restrict__ gp = g.gate + (size_t)tok_seq(row) * 12288;
            const float* __restrict__ xi = g.xin ? g.xin + (size_t)row * 2048 : xin_row(p, row);
#pragma unroll
            for (int n = 0; n < NF; ++n) { xv[j][n] = xi[cb + n * 16]; gv[j][n] = gp[cb + n * 16]; }
          }
#pragma unroll
          for (int j = 0; j < 4; ++j) {
            float* xo = g.xout + (size_t)(rb + m * 16 + j) * 2048;
#pragma unroll
            for (int n = 0; n < NF; ++n) xo[cb + n * 16] = xv[j][n] + gv[j][n] * acc[m][n][j];
          }
        }
    } else if (EPI == EPI_SWIGLU) {
      const int f0 = ((bcol + wc * 64) >> 1) + fr;
#pragma unroll
      for (int m = 0; m < MF; ++m)
#pragma unroll
        for (int j = 0; j < 4; ++j) {
          int row = rb + m * 16 + j;
#pragma unroll
          for (int n = 0; n < 2; ++n) g.H[(size_t)row * FFN + f0 + n * 16] = f2bf(siluf_(acc[m][n][j]) * acc[m][n + 2][j]);
        }
    } else {
      float* abuf = p.R2;
      float* ubuf = p.R2 + (size_t)NTOK * 2048;
      float xcv[2][MF][4];
#pragma unroll
      for (int n = 0; n < 2; ++n)
#pragma unroll
        for (int m = 0; m < MF; ++m)
#pragma unroll
          for (int j = 0; j < 4; ++j) xcv[n][m][j] = ubuf[(size_t)(rb + m * 16 + j) * 2048 + nt_cur * 64 + wc * 32 + n * 16 + fr];
      float aggA_w[2], aggU_w[2];
#pragma unroll
      for (int n = 0; n < 2; ++n) {
        const int ch = nt_cur * 64 + wc * 32 + n * 16 + fr;
        const float ba = p.lru_b_a[ch], bx = p.lru_b_x[ch];
        const float sp = log1pf(expf(-p.lru_lambda[ch]));
        float Aw = 1.f, Uw = 0.f;
#pragma unroll
        for (int m = 0; m < MF; ++m) {
          float Al = 1.f, Ul = 0.f;
#pragma unroll
          for (int j = 0; j < 4; ++j) {
            int row = rb + m * 16 + j;
            float rr = 1.f / (1.f + expf(-(acc[m][n][j] + ba)));
            float ii = 1.f / (1.f + expf(-(acc[m][n + 2][j] + bx)));
            float la = -8.f * rr * sp;
            float av = expf(la);
            float mult = sqrtf(-expm1f(2.f * la));
            float uv = mult * ii * xcv[n][m][j];
            size_t o = (size_t)row * 2048 + ch;
            abuf[o] = av;
            ubuf[o] = uv;
            Ul = av * Ul + uv; Al *= av;
          }
          {
            float Ap = __shfl_xor(Al, 16), Up = __shfl_xor(Ul, 16);
            if ((fq & 1) == 0) { Ul = Ap * Ul + Up; Al = Ap * Al; } else { Ul = Al * Up + Ul; Al = Al * Ap; }
            Ap = __shfl_xor(Al, 32); Up = __shfl_xor(Ul, 32);
            if ((fq & 2) == 0) { Ul = Ap * Ul + Up; Al = Ap * Al; } else { Ul = Al * Up + Ul; Al = Al * Ap; }
          }
          Uw = Al * Uw + Ul; Aw = Al * Aw;
        }
        aggA_w[n] = Aw; aggU_w[n] = Uw;
      }
      {
        float* sg = (float*)(smem + STAGE_B);
        if (fq == 0) {
#pragma unroll
          for (int n = 0; n < 2; ++n) { float* d = sg + ((((wr * 2 + wc) * 2 + n) * 16 + fr) << 1); d[0] = aggA_w[n]; d[1] = aggU_w[n]; }
        }
        __syncthreads();
        if (mt_cur < 32 && tid < 128) {
          const int c2 = tid >> 6, rest = tid & 63, wc2 = rest >> 5, n2 = (rest >> 4) & 1, fr2 = rest & 15;
          const float* s0 = sg + (((((2 * c2) * 2 + wc2) * 2 + n2) * 16 + fr2) << 1);
          const float* s1 = sg + (((((2 * c2 + 1) * 2 + wc2) * 2 + n2) * 16 + fr2) << 1);
          const int ch2 = nt_cur * 64 + wc2 * 32 + n2 * 16 + fr2;
          const int chunk = mt_cur * 2 + c2;
          p.aggA[chunk * 2048 + ch2] = s1[0] * s0[0];
          p.aggU[chunk * 2048 + ch2] = s1[0] * s0[1] + s1[1];
        }
        __syncthreads();
      }
    }
  }
}

__device__ __forceinline__ void post_proj_item(const Params& p, int item) {
  const int tid = (tidx_opaque() & 255), lane = tid & 63, wave = tid >> 6;
  const int tokb = item * 2;
  int seq, t0, pos0, T;
  tok_info(tokb, seq, t0, pos0, T);
  const float* __restrict__ prb = p.R1 + (size_t)tokb * ABN;
  float q1[2][2], q2[2][2], kv1[2], kv2[2], i1[2][2], i2[2][2], m1[2], m2[2], u[2][6][4], cw[6][5];
#pragma unroll
  for (int k = 0; k < 2; ++k) {
    const float* __restrict__ pr = prb + k * ABN;
    const int t = t0 + k;
#pragma unroll
    for (int rd = 0; rd < 2; ++rd) { int h = rd * 4 + wave; q1[k][rd] = pr[h * 128 + lane]; q2[k][rd] = pr[h * 128 + 64 + lane]; }
    kv1[k] = pr[1024 + wave * 128 + lane]; kv2[k] = pr[1024 + wave * 128 + 64 + lane];
#pragma unroll
    for (int rd = 0; rd < 2; ++rd) { int pair = tid + 256 * rd; int h = pair >> 5, i = pair & 31; i1[k][rd] = pr[1536 + h * 64 + i]; i2[k][rd] = pr[1536 + h * 64 + 32 + i]; }
    m1[k] = 0.f; m2[k] = 0.f;
    if (tid < 32) { m1[k] = pr[2560 + tid]; m2[k] = pr[2560 + 32 + tid]; }
    else if (tid < 48) m1[k] = pr[2624 + (tid - 32)];
    else if (tid >= 64 && tid < 80) m1[k] = pr[5200 + (tid - 64)] + p.ssd_dt_bias[tid - 64];
#pragma unroll
    for (int i = 0; i < 6; ++i) {
      int c = tid + 256 * i;
#pragma unroll
      for (int d = 0; d < 4; ++d) {
        int tt = t - d;
        if (tt >= 0) u[k][i][d] = pr[3664 + c - d * ABN];
        else u[k][i][d] = seq < 2 ? 0.f : p.state_ssm_conv[((seq - 2) * 3 + (3 + tt)) * 1536 + c];
      }
    }
  }
#pragma unroll
  for (int i = 0; i < 6; ++i) {
    int c = tid + 256 * i;
    cw[i][0] = p.ssd_conv_w[c]; cw[i][1] = p.ssd_conv_w[1536 + c]; cw[i][2] = p.ssd_conv_w[2 * 1536 + c];
    cw[i][3] = p.ssd_conv_w[3 * 1536 + c]; cw[i][4] = p.ssd_conv_b[c];
  }
  const float qw1 = p.q_norm_w[lane], qw2 = p.q_norm_w[64 + lane], kw1 = p.k_norm_w[lane], kw2 = p.k_norm_w[64 + lane];
#pragma unroll
  for (int k = 0; k < 2; ++k) {
    const int tok = tokb + k, t = t0 + k, pos = pos0 + k;
    const int kvrow = kv_base(seq) + pos;
    const float fpos = (float)pos;
    float* kout = tok < 8192 ? p.out + O_KP + (size_t)tok * 256 : p.out + O_KS + (size_t)(tok - 8192) * 256;
    float* vout = tok < 8192 ? p.out + O_VP + (size_t)tok * 256 : p.out + O_VS + (size_t)(tok - 8192) * 256;
    float* kiout = tok < 8192 ? p.out + O_KIP + (size_t)tok * 64 : p.out + O_KIS + (size_t)(tok - 8192) * 64;
    float c64, s64;
    rope_cs(fpos, lane, 1.f / 64.f, c64, s64);
#pragma unroll
    for (int rd = 0; rd < 2; ++rd) {
      int h = rd * 4 + wave;
      float x1 = q1[k][rd], x2 = q2[k][rd];
      float ss = wave_sum(x1 * x1 + x2 * x2);
      float rn = rsqrtf(ss * (1.f / 128.f) + 1e-6f);
      x1 *= rn * qw1;
      x2 *= rn * qw2;
      u16* q = p.qb + ((size_t)tok * 8 + h) * 128;
      q[lane] = f2bf(x1 * c64 - x2 * s64);
      q[64 + lane] = f2bf(x1 * s64 + x2 * c64);
    }
    if (wave < 2) {
      int h = wave;
      float x1 = kv1[k], x2 = kv2[k];
      float ss = wave_sum(x1 * x1 + x2 * x2);
      float rn = rsqrtf(ss * (1.f / 128.f) + 1e-6f);
      x1 *= rn * kw1;
      x2 *= rn * kw2;
      float o1 = x1 * c64 - x2 * s64, o2 = x1 * s64 + x2 * c64;
      kout[h * 128 + lane] = o1; kout[h * 128 + 64 + lane] = o2;
      u16* kb = p.Kb + (size_t)kvrow * 256 + h * 128;
      kb[lane] = f2bf(o1); kb[64 + lane] = f2bf(o2);
    } else {
      int h = wave - 2;
      vout[h * 128 + lane] = kv1[k]; vout[h * 128 + 64 + lane] = kv2[k];
      u16* vb = p.Vb + (size_t)kvrow * 256 + h * 128;
      vb[lane] = f2bf(kv1[k]); vb[64 + lane] = f2bf(kv2[k]);
    }
#pragma unroll
    for (int rd = 0; rd < 2; ++rd) {
      int pair = tid + 256 * rd;
      int h = pair >> 5, i = pair & 31;
      float c, s;
      rope_cs(fpos, i, 1.f / 32.f, c, s);
      u16* q = p.qib + ((size_t)tok * 16 + h) * 64;
      q[i] = f2bf(i1[k][rd] * c - i2[k][rd] * s);
      q[32 + i] = f2bf(i1[k][rd] * s + i2[k][rd] * c);
    }
    if (tid < 32) {
      float c, s;
      rope_cs(fpos, tid, 1.f / 32.f, c, s);
      float o1 = m1[k] * c - m2[k] * s, o2 = m1[k] * s + m2[k] * c;
      kiout[tid] = o1; kiout[32 + tid] = o2;
      u16* kb = p.kib + (size_t)kvrow * 64;
      kb[tid] = f2bf(o1); kb[32 + tid] = f2bf(o2);
    } else if (tid < 48) {
      p.wi[tok * 16 + (tid - 32)] = m1[k] * (0.25f * 0.125f);
    } else if (tid >= 64 && tid < 80) {
      p.dt[tok * 16 + (tid - 64)] = m1[k] > 20.f ? m1[k] : log1pf(expf(m1[k]));
    }
#pragma unroll
    for (int i = 0; i < 6; ++i) {
      int c = tid + 256 * i;
      float o = cw[i][4] + cw[i][3] * u[k][i][0] + cw[i][2] * u[k][i][1] + cw[i][1] * u[k][i][2] + cw[i][0] * u[k][i][3];
      o = siluf_(o);
      if (c < 1024) p.xs[(size_t)tok * 1024 + c] = o;
      else if (c < 1280) p.bm[(size_t)tok * 256 + (c - 1024)] = o;
      else p.cm[(size_t)tok * 256 + (c - 1280)] = o;
      if (t >= T - 3) {
        int j = t - (T - 3);
        float* dst = seq < 2 ? p.out + O_SSMCP + (seq * 3 + j) * 1536 : p.out + O_SSMCS + ((seq - 2) * 3 + j) * 1536;
        dst[c] = u[k][i][0];
      }
    }
  }
}

__device__ __forceinline__ void idx_item(const Params& p, int item) {
  const int tid = (tidx_opaque() & 255), lane = tid & 63, wave = tid >> 6;
  const int tg = item >> 2, kq = item & 3;
  const int tok0 = tg * 16;
  int seq, t, pos, T;
  tok_info(tok0, seq, t, pos, T);
  const int nkeys = seq < 2 ? ((t >> 6) + 1) * 64 : 1056;
  const int kbeg = kq * 1024;
  const int kend = min(nkeys, kbeg + 1024);
  if (kbeg >= kend) return;
  const int tokw = tok0 + wave * 4;
  const int r = lane & 31, hh = lane >> 5;
  const int tk = (r >> 2) & 1, hd = (r & 3) + 4 * (r >> 3);
  bf16x8 a[2][4];
  float wv[2][16];
#pragma unroll
  for (int pr = 0; pr < 2; ++pr) {
#pragma unroll
    for (int ks = 0; ks < 4; ++ks)
      a[pr][ks] = *(const bf16x8*)(p.qib + ((size_t)(tokw + pr * 2 + tk) * 16 + hd) * 64 + ks * 16 + hh * 8);
    const float4* wp = (const float4*)(p.wi + (tokw + pr * 2 + hh) * 16);
#pragma unroll
    for (int q = 0; q < 4; ++q) { float4 w = wp[q]; wv[pr][q * 4] = w.x; wv[pr][q * 4 + 1] = w.y; wv[pr][q * 4 + 2] = w.z; wv[pr][q * 4 + 3] = w.w; }
  }
  const int kvb = kv_base(seq);
  float* score = p.R2;
  bf16x8 b[4];
#pragma unroll
  for (int ks = 0; ks < 4; ++ks) b[ks] = *(const bf16x8*)(p.kib + (size_t)(kvb + kbeg + r) * 64 + ks * 16 + hh * 8);
  for (int k0 = kbeg; k0 < kend; k0 += 32) {
    bf16x8 bn[4];
    const int kn = (k0 + 32 < kend) ? k0 + 32 : k0;
#pragma unroll
    for (int ks = 0; ks < 4; ++ks) bn[ks] = *(const bf16x8*)(p.kib + (size_t)(kvb + kn + r) * 64 + ks * 16 + hh * 8);
#pragma unroll
    for (int pr = 0; pr < 2; ++pr) {
      f32x16 acc = zero16();
#pragma unroll
      for (int ks = 0; ks < 4; ++ks) acc = __builtin_amdgcn_mfma_f32_32x32x16_bf16(a[pr][ks], b[ks], acc, 0, 0, 0);
      float sc = 0.f;
#pragma unroll
      for (int q = 0; q < 16; ++q) sc += wv[pr][q] * fmaxf(acc[q], 0.f);
      score[(size_t)(tokw + pr * 2 + hh) * 4096 + k0 + r] = sc;
    }
#pragma unroll
    for (int ks = 0; ks < 4; ++ks) b[ks] = bn[ks];
  }
}

__device__ __forceinline__ void ssd_decode(int it, int& seq, int& tok0, int& L, int& h) {
  if (it < 2048) { seq = it >> 10; int c = (it >> 4) & 63; h = it & 15; L = 64; tok0 = seq * 4096 + c * 64; }
  else { int r = it - 2048; int sq = r >> 4; h = r & 15; seq = 2 + sq; L = 32; tok0 = 8192 + sq * 32; }
}

__device__ __forceinline__ void ssd_s1_item(const Params& p, int it, float* sm) {
  const int tid = (tidx_opaque() & 255), lane = tid & 63, wave = tid >> 6;
  const int r = lane & 31, hh = lane >> 5;
  float* xw = sm;
  float* Bs = sm + 4096;
  float* s_cum = Bs + 8192;
  float* s_w = s_cum + 64;
  int seq, tok0, L, h;
  ssd_decode(it, seq, tok0, L, h);
  const int g = h >> 3;
  const float a_neg = -expf(p.ssd_a_log[h]);
  float4 xr[4], br[8];
#pragma unroll
  for (int i = 0; i < 4; ++i) {
    int idx4 = tid + 256 * i;
    int s = idx4 >> 4, c4 = idx4 & 15;
    xr[i] = make_float4(0.f, 0.f, 0.f, 0.f);
    if (s < L) xr[i] = *(const float4*)(p.xs + (size_t)(tok0 + s) * 1024 + h * 64 + c4 * 4);
  }
#pragma unroll
  for (int i = 0; i < 8; ++i) {
    int idx4 = tid + 256 * i;
    int s = idx4 >> 5, c4 = idx4 & 31;
    br[i] = make_float4(0.f, 0.f, 0.f, 0.f);
    if (s < L) br[i] = *(const float4*)(p.bm + (size_t)(tok0 + s) * 256 + g * 128 + c4 * 4);
  }
  if (wave == 0) {
    float dtv = lane < L ? p.dt[(tok0 + lane) * 16 + h] : 0.f;
    float v = dtv * a_neg;
#pragma unroll
    for (int o = 1; o < 64; o <<= 1) { float n = __shfl_up(v, o); if (lane >= o) v += n; }
    if (lane < L) p.cumb[(tok0 + lane) * 16 + h] = v;
    s_cum[lane] = v;
    float last = __shfl(v, L - 1);
    s_w[lane] = lane < L ? expf(last - v) * dtv : 0.f;
  }
  __syncthreads();
#pragma unroll
  for (int i = 0; i < 4; ++i) {
    int idx4 = tid + 256 * i;
    int s = idx4 >> 4, c4 = idx4 & 15;
    float w = s_w[s];
    *(float4*)(xw + s * 64 + c4 * 4) = make_float4(xr[i].x * w, xr[i].y * w, xr[i].z * w, xr[i].w * w);
  }
#pragma unroll
  for (int i = 0; i < 8; ++i) {
    int idx4 = tid + 256 * i;
    int s = idx4 >> 5, c4 = idx4 & 31;
    *(float4*)(Bs + s * 128 + c4 * 4) = br[i];
  }
  __syncthreads();
  const int pi = wave & 1, nj0 = (wave >> 1) * 2;
  f32x16 acc0 = zero16(), acc1 = zero16();
  for (int kb = 0; kb < L / 2; kb += 8) {
    float a[8], b0[8], b1[8];
#pragma unroll
    for (int q = 0; q < 8; ++q) {
      int k = 2 * (kb + q) + hh;
      a[q] = xw[k * 64 + pi * 32 + r];
      b0[q] = Bs[k * 128 + nj0 * 32 + r];
      b1[q] = Bs[k * 128 + nj0 * 32 + 32 + r];
    }
    __builtin_amdgcn_s_setprio(1);
#pragma unroll
    for (int q = 0; q < 8; ++q) {
      acc0 = __builtin_amdgcn_mfma_f32_32x32x2f32(a[q], b0[q], acc0, 0, 0, 0);
      acc1 = __builtin_amdgcn_mfma_f32_32x32x2f32(a[q], b1[q], acc1, 0, 0, 0);
    }
    __builtin_amdgcn_s_setprio(0);
  }
  const float declast = expf(s_cum[L - 1]);
  if (seq < 2) {
#pragma unroll
    for (int j = 0; j < 2; ++j) {
      const f32x16& a = j == 0 ? acc0 : acc1;
#pragma unroll
      for (int q = 0; q < 16; ++q) {
        int pp = pi * 32 + (q & 3) + 8 * (q >> 2) + 4 * hh;
        int n = (nj0 + j) * 32 + r;
        p.xcur[(size_t)it * 8192 + pp * 128 + n] = a[q];
      }
    }
  } else {
    const size_t ob = (size_t)((seq - 2) * 16 + h) * 8192;
    float h0v[2][16];
#pragma unroll
    for (int j = 0; j < 2; ++j)
#pragma unroll
      for (int q = 0; q < 16; ++q) {
        int pp = pi * 32 + (q & 3) + 8 * (q >> 2) + 4 * hh;
        h0v[j][q] = p.state_ssm[ob + pp * 128 + (nj0 + j) * 32 + r];
      }
#pragma unroll
    for (int j = 0; j < 2; ++j) {
      const f32x16& a = j == 0 ? acc0 : acc1;
#pragma unroll
      for (int q = 0; q < 16; ++q) {
        int pp = pi * 32 + (q & 3) + 8 * (q >> 2) + 4 * hh;
        p.out[O_SSMS + ob + pp * 128 + (nj0 + j) * 32 + r] = declast * h0v[j][q] + a[q];
      }
    }
  }
  __syncthreads();
}

__device__ __forceinline__ void ssd_s2_item(const Params& p, int it) {
  const int seq = it >> 9, h = (it >> 5) & 15, e = (it & 31) * 256 + (tidx_opaque() & 255);
  float* __restrict__ S = p.xcur + (size_t)(seq * 64 * 16 + h) * 8192 + e;
  const float* __restrict__ cum = p.cumb + (seq * 4096 + 63) * 16 + h;
  float hst = 0.f;
  for (int c0 = 0; c0 < 64; c0 += 8) {
    float tmp[8], dec[8];
#pragma unroll
    for (int i = 0; i < 8; ++i) { tmp[i] = S[(size_t)(c0 + i) * 16 * 8192]; dec[i] = cum[(c0 + i) * 64 * 16]; }
#pragma unroll
    for (int i = 0; i < 8; ++i) {
      S[(size_t)(c0 + i) * 16 * 8192] = hst;
      hst = expf(dec[i]) * hst + tmp[i];
    }
  }
  p.out[O_SSMP + (size_t)(seq * 16 + h) * 8192 + e] = hst;
}

__device__ __forceinline__ void ssd_s3_item(const Params& p, int it, float* sm) {
  const int tid = (tidx_opaque() & 255), lane = tid & 63, wave = tid >> 6;
  const int r = lane & 31, hh = lane >> 5;
  float* bufA = sm;
  float* bufB = sm + 4160;
  float* Wb = sm + 8320;
  float* xb = sm + 12480;
  float* s_cum = sm + 16576;
  float* s_dt = s_cum + 64;
  int seq, tok0, L, h;
  ssd_decode(it, seq, tok0, L, h);
  const int g = h >> 3;
  const int ti = wave >> 1, si = wave & 1, pi = wave & 1;
  const float* hprev = seq < 2 ? p.xcur + (size_t)it * 8192 : p.state_ssm + (size_t)((seq - 2) * 16 + h) * 8192;
  float4 cr[2][4], br[2][4], hr[2][4], xr[4];
  float zr[16];
#pragma unroll
  for (int nh = 0; nh < 2; ++nh)
#pragma unroll
    for (int i = 0; i < 4; ++i) {
      int idx4 = tid + 256 * i;
      int s = idx4 >> 4, c4 = idx4 & 15;
      cr[nh][i] = make_float4(0.f, 0.f, 0.f, 0.f);
      br[nh][i] = cr[nh][i];
      if (s < L) {
        cr[nh][i] = *(const float4*)(p.cm + (size_t)(tok0 + s) * 256 + g * 128 + nh * 64 + c4 * 4);
        br[nh][i] = *(const float4*)(p.bm + (size_t)(tok0 + s) * 256 + g * 128 + nh * 64 + c4 * 4);
      }
      hr[nh][i] = *(const float4*)(hprev + s * 128 + nh * 64 + c4 * 4);
    }
#pragma unroll
  for (int i = 0; i < 4; ++i) {
    int idx4 = tid + 256 * i;
    int s = idx4 >> 4, c4 = idx4 & 15;
    xr[i] = make_float4(0.f, 0.f, 0.f, 0.f);
    if (s < L) xr[i] = *(const float4*)(p.xs + (size_t)(tok0 + s) * 1024 + h * 64 + c4 * 4);
  }
#pragma unroll
  for (int q = 0; q < 16; ++q) {
    int t = ti * 32 + (q & 3) + 8 * (q >> 2) + 4 * hh;
    zr[q] = t < L ? p.R1[(size_t)(tok0 + t) * ABN + 2640 + h * 64 + pi * 32 + r] : 0.f;
  }
  if (tid < 64) {
    s_cum[tid] = tid < L ? p.cumb[(tok0 + tid) * 16 + h] : 0.f;
    s_dt[tid] = tid < L ? p.dt[(tok0 + tid) * 16 + h] : 0.f;
  }
#define ST4(dst, v) do { float* _d = (dst); _d[0] = (v).x; _d[1] = (v).y; _d[2] = (v).z; _d[3] = (v).w; } while (0)
#define MM32(acc, pa, pb)                                                        \
  for (int kb = 0; kb < 32; kb += 8) {                                           \
    float _a[8], _b[8];                                                          \
    _Pragma("unroll") for (int q = 0; q < 8; ++q) { _a[q] = (pa)[2 * (kb + q)]; _b[q] = (pb)[2 * (kb + q)]; } \
    __builtin_amdgcn_s_setprio(1);                                             \
    _Pragma("unroll") for (int q = 0; q < 8; ++q) acc = __builtin_amdgcn_mfma_f32_32x32x2f32(_a[q], _b[q], acc, 0, 0, 0); \
    __builtin_amdgcn_s_setprio(0);                                             \
  }
  f32x16 cb = zero16();
#pragma unroll
  for (int nh = 0; nh < 2; ++nh) {
#pragma unroll
    for (int i = 0; i < 4; ++i) {
      int idx4 = tid + 256 * i;
      int s = idx4 >> 4, c4 = idx4 & 15;
      ST4(bufA + s * 65 + c4 * 4, cr[nh][i]);
      ST4(bufB + s * 65 + c4 * 4, br[nh][i]);
    }
    __syncthreads();
    {
      const float* pa = bufA + (ti * 32 + r) * 65 + hh;
      const float* pb = bufB + (si * 32 + r) * 65 + hh;
      MM32(cb, pa, pb)
    }
    __syncthreads();
  }
  {
    const int s = si * 32 + r;
    const float cs = s_cum[s], ds = s_dt[s];
#pragma unroll
    for (int q = 0; q < 16; ++q) {
      int t = ti * 32 + (q & 3) + 8 * (q >> 2) + 4 * hh;
      float val = (s <= t) ? cb[q] * expf(s_cum[t] - cs) * ds : 0.f;
      Wb[t * 65 + s] = val;
    }
  }
#pragma unroll
  for (int i = 0; i < 4; ++i) {
    int idx4 = tid + 256 * i;
    int s = idx4 >> 4, c4 = idx4 & 15;
    *(float4*)(xb + s * 64 + c4 * 4) = xr[i];
  }
#pragma unroll
  for (int i = 0; i < 4; ++i) {
    int idx4 = tid + 256 * i;
    int s = idx4 >> 4, c4 = idx4 & 15;
    ST4(bufA + s * 65 + c4 * 4, cr[0][i]);
    ST4(bufB + s * 65 + c4 * 4, hr[0][i]);
  }
  __syncthreads();
  f32x16 y1 = zero16(), y2 = zero16();
  for (int kb = 0; kb < 32; kb += 8) {
    float a[8], b[8];
#pragma unroll
    for (int q = 0; q < 8; ++q) { a[q] = Wb[(ti * 32 + r) * 65 + 2 * (kb + q) + hh]; b[q] = xb[(2 * (kb + q) + hh) * 64 + pi * 32 + r]; }
    __builtin_amdgcn_s_setprio(1);
#pragma unroll
    for (int q = 0; q < 8; ++q) y1 = __builtin_amdgcn_mfma_f32_32x32x2f32(a[q], b[q], y1, 0, 0, 0);
    __builtin_amdgcn_s_setprio(0);
  }
  {
    const float* pa = bufA + (ti * 32 + r) * 65 + hh;
    const float* pb = bufB + (pi * 32 + r) * 65 + hh;
    MM32(y2, pa, pb)
  }
  __syncthreads();
#pragma unroll
  for (int i = 0; i < 4; ++i) {
    int idx4 = tid + 256 * i;
    int s = idx4 >> 4, c4 = idx4 & 15;
    ST4(bufA + s * 65 + c4 * 4, cr[1][i]);
    ST4(bufB + s * 65 + c4 * 4, hr[1][i]);
  }
  __syncthreads();
  {
    const float* pa = bufA + (ti * 32 + r) * 65 + hh;
    const float* pb = bufB + (pi * 32 + r) * 65 + hh;
    MM32(y2, pa, pb)
  }
  {
    const int pc = pi * 32 + r;
    const float Dh = p.ssd_d[h];
#pragma unroll
    for (int q = 0; q < 16; ++q) {
      int t = ti * 32 + (q & 3) + 8 * (q >> 2) + 4 * hh;
      if (t < L) {
        int tok = tok0 + t;
        float y = y1[q] + expf(s_cum[t]) * y2[q] + Dh * xb[t * 64 + pc];
        float z = zr[q];
        p.R2[(size_t)tok * 1024 + h * 64 + pc] = y * siluf_(z);
      }
    }
  }
#undef ST4
#undef MM32
  __syncthreads();
}

__device__ __forceinline__ void phase_ssdnorm(const Params& p) {
  const int lane = (tidx_opaque() & 255) & 63, wave = (tidx_opaque() & 255) >> 6;
  FOR_ITEMS(NTOK * 2 / 4, it) {
    int pair = it * 4 + wave;
    int tok = pair >> 1, g = pair & 1;
    const float* y = p.R2 + (size_t)tok * 1024 + g * 512 + lane * 8;
    float4 v0 = *(const float4*)y, v1 = *(const float4*)(y + 4);
    float ss = v0.x * v0.x + v0.y * v0.y + v0.z * v0.z + v0.w * v0.w + v1.x * v1.x + v1.y * v1.y + v1.z * v1.z + v1.w * v1.w;
    ss = wave_sum(ss);
    float rn = rsqrtf(ss * (1.f / 512.f) + 1e-6f);
    const float* w = p.ssd_norm_w + g * 512 + lane * 8;
    float4 w0 = *(const float4*)w, w1 = *(const float4*)(w + 4);
    uint4 o;
    o.x = pack2(v0.x * rn * w0.x, v0.y * rn * w0.y);
    o.y = pack2(v0.z * rn * w0.z, v0.w * rn * w0.w);
    o.z = pack2(v1.x * rn * w1.x, v1.y * rn * w1.y);
    o.w = pack2(v1.z * rn * w1.z, v1.w * rn * w1.w);
    *(uint4*)(p.Abuf + (size_t)tok * 2048 + 1024 + g * 512 + lane * 8) = o;
  }
}

__device__ __forceinline__ unsigned ord_u(float f) {
  unsigned u = __float_as_uint(f);
  return (u & 0x80000000u) ? ~u : (u | 0x80000000u);
}
template <int NREG>
__device__ __forceinline__ void topk_wave(const float* sc, int nkeys, int* selout, int lane) {
  unsigned v[NREG];
#pragma unroll
  for (int r = 0; r < NREG; ++r) {
    int key = r * 64 + lane;
    v[r] = key < nkeys ? ord_u(sc[key]) : 0u;
  }
  unsigned prefix = 0;
#pragma unroll 1
  for (int bit = 31; bit >= 0; --bit) {
    unsigned cand = prefix | (1u << bit);
    int cnt = 0;
#pragma unroll
    for (int r = 0; r < NREG; ++r) cnt += __popcll(__ballot(v[r] >= cand));
    if (cnt >= 256) prefix = cand;
  }
  int cgt = 0;
#pragma unroll
  for (int r = 0; r < NREG; ++r) cgt += __popcll(__ballot(v[r] > prefix));
  const int need = 256 - cgt;
  int base = 0, tie_taken = 0;
#pragma unroll
  for (int r = 0; r < NREG; ++r) {
    bool gt = v[r] > prefix, eq = v[r] == prefix;
    unsigned long long em = __ballot(eq);
    int erank = __builtin_amdgcn_mbcnt_hi((unsigned)(em >> 32), __builtin_amdgcn_mbcnt_lo((unsigned)em, 0));
    bool take = gt || (eq && (tie_taken + erank < need));
    tie_taken += __popcll(em);
    unsigned long long m = __ballot(take);
    int pos = base + __builtin_amdgcn_mbcnt_hi((unsigned)(m >> 32), __builtin_amdgcn_mbcnt_lo((unsigned)m, 0));
    if (take && pos < 256) selout[pos] = r * 64 + lane;
    base += __popcll(m);
  }
}

__device__ __forceinline__ void topk_item(const Params& p, int item) {
  const int lane = (tidx_opaque() & 255) & 63, wave = (tidx_opaque() & 255) >> 6;
  const int tok = item * 4 + wave;
  int seq, t, pos, T;
  tok_info(tok, seq, t, pos, T);
  const int nkeys = seq < 2 ? ((t >> 6) + 1) * 64 : 1056;
  int* so = p.sel + (size_t)tok * 256;
  const float* sc = p.R2 + (size_t)tok * 4096;
  if (nkeys <= 256) {
#pragma unroll
    for (int i = 0; i < 4; ++i) so[i * 64 + lane] = i * 64 + lane;
    return;
  }
  if (nkeys <= 1024) topk_wave<16>(sc, nkeys, so, lane);
  else if (nkeys <= 1088) topk_wave<17>(sc, nkeys, so, lane);
  else if (nkeys <= 2048) topk_wave<32>(sc, nkeys, so, lane);
  else topk_wave<64>(sc, nkeys, so, lane);
}

__device__ __forceinline__ void attn_item(const Params& p, int tok0, int g, char* smem) {
  const int tid = (tidx_opaque() & 255), lane = tid & 63, wave = tid >> 6;
  float* qs = (float*)smem + wave * 1792;
  float* ps = qs + 512;
  int* rows = (int*)(ps + 1024);
  const int tok = tok0 + wave;
  int seq, t, pos, T;
  tok_info(tok, seq, t, pos, T);
  const int nkeys = seq < 2 ? ((t >> 6) + 1) * 64 : 1056;
  const int nsel = min(nkeys, 256);
  const int nkb = nsel >> 4;
  const int kvb = kv_base(seq);
  const int c16 = lane & 15, q4 = lane >> 4;
  bf16x8 qa[4];
#pragma unroll
  for (int ks = 0; ks < 4; ++ks) {
#pragma unroll
    for (int e = 0; e < 8; ++e) qa[ks][e] = 0;
    if (c16 < 4) qa[ks] = *(const bf16x8*)(p.qb + ((size_t)tok * 8 + g * 4 + c16) * 128 + ks * 32 + q4 * 8);
  }
#pragma unroll
  for (int i = 0; i < 4; ++i) {
    int j = i * 64 + lane;
    int idx = (j < nsel) ? p.sel[(size_t)tok * 256 + j] : 0;
    rows[j] = kvb + idx;
  }
  __builtin_amdgcn_wave_barrier();
  f32x4 sacc[16];
#pragma unroll
  for (int kb = 0; kb < 16; ++kb) {
    sacc[kb][0] = -INFINITY; sacc[kb][1] = -INFINITY; sacc[kb][2] = -INFINITY; sacc[kb][3] = -INFINITY;
    if (kb < nkb) {
      const int row = rows[kb * 16 + c16];
      const u16* kp = p.Kb + (size_t)row * 256 + g * 128 + q4 * 8;
      bf16x8 b0 = *(const bf16x8*)(kp), b1 = *(const bf16x8*)(kp + 32), b2 = *(const bf16x8*)(kp + 64), b3 = *(const bf16x8*)(kp + 96);
      f32x4 acc = {0.f, 0.f, 0.f, 0.f};
      acc = __builtin_amdgcn_mfma_f32_16x16x32_bf16(qa[0], b0, acc, 0, 0, 0);
      acc = __builtin_amdgcn_mfma_f32_16x16x32_bf16(qa[1], b1, acc, 0, 0, 0);
      acc = __builtin_amdgcn_mfma_f32_16x16x32_bf16(qa[2], b2, acc, 0, 0, 0);
      acc = __builtin_amdgcn_mfma_f32_16x16x32_bf16(qa[3], b3, acc, 0, 0, 0);
      sacc[kb] = acc;
    }
  }
  const float scl = 0.08838834764831845f;
#pragma unroll
  for (int i = 0; i < 4; ++i) {
    float m = sacc[0][i];
#pragma unroll
    for (int kb = 1; kb < 16; ++kb) m = fmaxf(m, sacc[kb][i]);
#pragma unroll
    for (int o = 8; o > 0; o >>= 1) m = fmaxf(m, __shfl_xor(m, o));
    float sum = 0.f;
#pragma unroll
    for (int kb = 0; kb < 16; ++kb) { float e = __expf((sacc[kb][i] - m) * scl); sacc[kb][i] = e; sum += e; }
#pragma unroll
    for (int o = 8; o > 0; o >>= 1) sum += __shfl_xor(sum, o);
    const float inv = 1.f / sum;
#pragma unroll
    for (int kb = 0; kb < 16; ++kb) sacc[kb][i] *= inv;
  }
  if (q4 == 0) {
#pragma unroll
    for (int kb = 0; kb < 16; ++kb) *(f32x4*)(ps + (kb * 16 + c16) * 4) = sacc[kb];
  }
  __builtin_amdgcn_wave_barrier();
  float o[4][2];
#pragma unroll
  for (int r = 0; r < 4; ++r) o[r][0] = o[r][1] = 0.f;
  const u16* vbase = p.Vb + g * 128 + lane * 2;
  for (int j0 = 0; j0 < nsel; j0 += 64) {
    unsigned vv[64];
#pragma unroll
    for (int u = 0; u < 64; u += 4) {
      int4 r4 = *(const int4*)(rows + j0 + u);
      vv[u + 0] = *(const unsigned*)(vbase + (size_t)r4.x * 256);
      vv[u + 1] = *(const unsigned*)(vbase + (size_t)r4.y * 256);
      vv[u + 2] = *(const unsigned*)(vbase + (size_t)r4.z * 256);
      vv[u + 3] = *(const unsigned*)(vbase + (size_t)r4.w * 256);
    }
#pragma unroll
    for (int u = 0; u < 64; ++u) {
      float4 p4 = *(const float4*)(ps + (j0 + u) * 4);
      float v0 = bflo(vv[u]), v1 = bfhi(vv[u]);
      o[0][0] += p4.x * v0; o[0][1] += p4.x * v1;
      o[1][0] += p4.y * v0; o[1][1] += p4.y * v1;
      o[2][0] += p4.z * v0; o[2][1] += p4.z * v1;
      o[3][0] += p4.w * v0; o[3][1] += p4.w * v1;
    }
  }
#pragma unroll
  for (int r = 0; r < 4; ++r)
    *(unsigned*)(p.Abuf + (size_t)tok * 2048 + (g * 4 + r) * 128 + lane * 2) = pack2(o[r][0], o[r][1]);
  __builtin_amdgcn_wave_barrier();
}

__device__ __forceinline__ void lru_conv_item(const Params& p, int tok) {
  const int tid = (tidx_opaque() & 255);
  int seq, t, pos, T;
  tok_info(tok, seq, t, pos, T);
  const float* gx = p.R1 + (size_t)tok * 4096 + 2048;
  float* xcf = p.R2 + (size_t)NTOK * 2048 + (size_t)tok * 2048;
  float4 u[2][4], w[2][5];
#pragma unroll
  for (int i = 0; i < 2; ++i) {
    int c = (tid + 256 * i) * 4;
#pragma unroll
    for (int d = 0; d < 4; ++d) {
      int tt = t - d;
      if (tt >= 0) u[i][d] = *(const float4*)(gx + c - d * 4096);
      else if (seq < 2) u[i][d] = make_float4(0.f, 0.f, 0.f, 0.f);
      else u[i][d] = *(const float4*)(p.state_lru_conv + ((seq - 2) * 3 + (3 + tt)) * 2048 + c);
    }
    w[i][0] = *(const float4*)(p.lru_conv_w + c); w[i][1] = *(const float4*)(p.lru_conv_w + 2048 + c);
    w[i][2] = *(const float4*)(p.lru_conv_w + 2 * 2048 + c); w[i][3] = *(const float4*)(p.lru_conv_w + 3 * 2048 + c);
    w[i][4] = *(const float4*)(p.lru_conv_b + c);
  }
#pragma unroll
  for (int i = 0; i < 2; ++i) {
    int c = (tid + 256 * i) * 4;
    float4 o;
    o.x = w[i][4].x + w[i][3].x * u[i][0].x + w[i][2].x * u[i][1].x + w[i][1].x * u[i][2].x + w[i][0].x * u[i][3].x;
    o.y = w[i][4].y + w[i][3].y * u[i][0].y + w[i][2].y * u[i][1].y + w[i][1].y * u[i][2].y + w[i][0].y * u[i][3].y;
    o.z = w[i][4].z + w[i][3].z * u[i][0].z + w[i][2].z * u[i][1].z + w[i][1].z * u[i][2].z + w[i][0].z * u[i][3].z;
    o.w = w[i][4].w + w[i][3].w * u[i][0].w + w[i][2].w * u[i][1].w + w[i][1].w * u[i][2].w + w[i][0].w * u[i][3].w;
    *(float4*)(xcf + c) = o;
    uint2 ob; ob.x = pack2(o.x, o.y); ob.y = pack2(o.z, o.w);
    *(uint2*)(p.Abuf + (size_t)tok * 2048 + c) = ob;
    if (t >= T - 3) {
      int j = t - (T - 3);
      float* dst = seq < 2 ? p.out + O_LRUCP + (seq * 3 + j) * 2048 : p.out + O_LRUCS + ((seq - 2) * 3 + j) * 2048;
      *(float4*)(dst + c) = u[i][0];
    }
  }
}

__device__ __forceinline__ void lru_agg_item(const Params& p, int it) {
  const int chunk = it >> 3, ch = (it & 7) * 256 + (tidx_opaque() & 255);
  const float* ab = p.R2 + (size_t)chunk * 128 * 2048 + ch;
  const float* ub = ab + (size_t)NTOK * 2048;
  float A = 1.f, h = 0.f;
#pragma unroll 8
  for (int t = 0; t < 128; ++t) {
    float a = ab[(size_t)t * 2048], u = ub[(size_t)t * 2048];
    h = a * h + u;
    A *= a;
  }
  p.aggA[chunk * 2048 + ch] = A;
  p.aggU[chunk * 2048 + ch] = h;
}

__device__ __forceinline__ float gelu_tanh(float x) {
  float y = 0.7978845608028654f * (x + 0.044715f * x * x * x);
  float e = __expf(2.f * y);
  float th = 1.f - 2.f / (e + 1.f);
  return 0.5f * x * (1.f + th);
}

__device__ __forceinline__ void lru_scan_item(const Params& p, int it) {
  int tok0, L, seq;
  const int ch = (it & 7) * 256 + (tidx_opaque() & 255);
  float h;
  bool last;
  if (it < 512) {
    int chunk = it >> 3;
    seq = chunk >> 5;
    int cs = chunk & 31;
    tok0 = chunk * 128; L = 128;
    h = 0.f;
    {
      const float* __restrict__ gA = p.aggA + seq * 32 * 2048 + ch;
      const float* __restrict__ gU = p.aggU + seq * 32 * 2048 + ch;
#pragma unroll 8
      for (int c = 0; c < cs; ++c) h = gA[c * 2048] * h + gU[c * 2048];
    }
    last = cs == 31;
  } else {
    int sq = (it - 512) >> 3;
    seq = 2 + sq;
    tok0 = 8192 + sq * 32; L = 32;
    h = p.state_lru[sq * 2048 + ch];
    last = true;
  }
  const float* ab = p.R2 + (size_t)tok0 * 2048 + ch;
  const float* ub = ab + (size_t)NTOK * 2048;
  const float* gt = p.R1 + (size_t)tok0 * 4096 + ch;
  u16* yo = p.Abuf + (size_t)tok0 * 2048 + ch;
#pragma unroll 8
  for (int t = 0; t < L; ++t) {
    float a = ab[(size_t)t * 2048], u = ub[(size_t)t * 2048], gv = gt[(size_t)t * 4096];
    h = a * h + u;
    yo[(size_t)t * 2048] = f2bf(h * gelu_tanh(gv));
  }
  if (last) {
    if (seq < 2) p.out[O_LRUP + seq * 2048 + ch] = h;
    else p.out[O_LRUS + (seq - 2) * 2048 + ch] = h;
  }
}

#define XB_TMO      128
#define XB_XCNT(j)  (256  + 64 * (j))
#define XB_XSUB(j)  (1280 + 64 * (j))
#define XB_XGEN(j)  (2304 + 64 * (j))
#define XB_TOP      3328
#define XB_TOPGEN   3392
#define XCD_BAR_WORDS 3456
#define XB_SPIN_CAP (1u << 18)
#define LAS __attribute__((address_space(3)))
__device__ __forceinline__ unsigned xb_ld(unsigned* p)              { return __hip_atomic_load(p, __ATOMIC_RELAXED, __HIP_MEMORY_SCOPE_AGENT); }
__device__ __forceinline__ unsigned xb_add(unsigned* p, unsigned v) { return __hip_atomic_fetch_add(p, v, __ATOMIC_RELAXED, __HIP_MEMORY_SCOPE_AGENT); }
__device__ __forceinline__ unsigned xb_xcc_id() { return (unsigned)__builtin_amdgcn_s_getreg((3 << 11) | 20) & 0xFu; }
#define XB_SPIN(cond, bar) do { unsigned _sp = 0; while (cond) { __builtin_amdgcn_s_sleep(1); \
    if ((++_sp & 255u) == 0u) { if (xb_ld(&(bar)[XB_TMO])) break; if (_sp > XB_SPIN_CAP) { atomicAdd(&(bar)[XB_TMO], 1u); break; } } } } while (0)
struct XcdBarrier { unsigned* bar; unsigned x; volatile LAS unsigned* st; };
__device__ __forceinline__ XcdBarrier xcd_barrier_post(unsigned* bar, volatile LAS unsigned* st) {
    XcdBarrier b; b.bar = bar; b.x = xb_xcc_id(); b.st = st;
    if (threadIdx.x == 0) (void)xb_add(&bar[XB_XCNT(b.x)], 1u);
    return b;
}
__device__ __forceinline__ void xcd_barrier_complete(unsigned* bar, unsigned x, unsigned& nloc, unsigned& nx) {
    const unsigned G = gridDim.x * gridDim.y * gridDim.z;
    unsigned sum, cnt, mine, sp = 0u;
    for (;;) {
        sum = 0u; cnt = 0u; mine = 0u;
#pragma unroll
        for (unsigned j = 0; j < 16; ++j) { const unsigned c = xb_ld(&bar[XB_XCNT(j)]); sum += c; cnt += (c > 0u) ? 1u : 0u; mine = (j == x) ? c : mine; }
        if (sum == G) break;
        __builtin_amdgcn_s_sleep(1);
        if ((++sp & 255u) == 0u) { if (xb_ld(&bar[XB_TMO])) break; if (sp > XB_SPIN_CAP) { atomicAdd(&bar[XB_TMO], 1u); break; } }
    }
    nloc = mine > 0u ? mine : 1u; nx = cnt > 0u ? cnt : 1u;
}
__device__ __forceinline__ void xcd_barrier(unsigned* bar, unsigned x, volatile LAS unsigned* st) {
    asm volatile("s_waitcnt vmcnt(0)" ::: "memory");
    __syncthreads();
    if (threadIdx.x == 0) {
        __builtin_amdgcn_s_waitcnt(0);
        unsigned nloc = st[0], nx = st[1];
        if (nloc == 0u) { xcd_barrier_complete(bar, x, nloc, nx); st[0] = nloc; st[1] = nx; }
        const unsigned old = xb_add(&bar[XB_XSUB(x)], 1u);
        const unsigned gen = old / nloc;
        if (old + 1u == (gen + 1u) * nloc) {
            __builtin_amdgcn_fence(__ATOMIC_RELEASE, "agent");
            asm volatile("s_waitcnt vmcnt(0)" ::: "memory");
            const unsigned og = xb_add(&bar[XB_TOP], 1u);
            const unsigned tg = og / nx;
            if (og + 1u == (tg + 1u) * nx) xb_add(&bar[XB_TOPGEN], 1u);
            else XB_SPIN(xb_ld(&bar[XB_TOPGEN]) == tg, bar);
            __builtin_amdgcn_fence(__ATOMIC_ACQUIRE, "agent");
            xb_add(&bar[XB_XGEN(x)], 1u);
            asm volatile("s_waitcnt vmcnt(0)" ::: "memory");
        } else {
            XB_SPIN(xb_ld(&bar[XB_XGEN(x)]) == gen, bar);
            __builtin_amdgcn_fence(__ATOMIC_ACQUIRE, "agent");
            asm volatile("s_waitcnt vmcnt(0)" ::: "memory");
        }
    }
    __syncthreads();
}

__device__ __forceinline__ void run_phase(const Params& p0, const int ph, char* smem, const bool dup = false) {
  const Params& p = opaque_params(p0);
  const float* mod0 = p.mod;
  const float* mod1 = p.mod + 18 * 12288;
  char* hsm = smem + (tidx_opaque() >> 8) * HALF_LDS;
  switch (ph) {
    case 0:
      FOR_ITEMS(1536 + 5984 + 4608, it) {
        if (it < 1536) ada_item(p, it, (float*)hsm);
        else if (it < 1536 + 5984) conv_item(p, it - 1536, (float*)hsm);
        else cache_item(p, it - 1536 - 5984);
      }
      break;
    case 1: phase_normmod<true>(p, nullptr, p.norm_mix_w, p.modp, 0, 2048); break;
    case 2: {
      GemmArgs g{}; g.A = p.Abuf; g.lda = 2048; g.B = p.Wt_in_ab; g.K = 2048; g.ntn = 21; g.ntiles = 34 * 21;
      g.C = p.R1; g.ldc = ABN; g.nvalid = ABN;
      gemm_phase<EPI_F32, 0>(p, g, smem);
    } break;
    case 3:
      FOR_ITEMS(NTOK / 2, it) post_proj_item(p, it);
      break;
    case 4:
      FOR_ITEMS(2176 + 2304, it) {
        if (it < 2304) ssd_s1_item(p, it, (float*)hsm);
        else idx_item(p, it - 2304);
      }
      break;
    case 5:
      FOR_ITEMS(1024 + 2176, it) {
        if (it < 1024) { if (!dup) ssd_s2_item(p, it); }
        else topk_item(p, it - 1024);
      }
      break;
    case 6:
      FOR_ITEMS(2304, it) { ssd_s3_item(p, it, (float*)hsm); }
      if (gridDim.x == 256) {
        const int hb = tidx_opaque() >> 8;
        const int b = blockIdx.x, x = b & 7, w = (b >> 3) * 2 + hb;
        const int tbase = (x >> 2) * 4096 + (x & 1) * 2048, gg = (x >> 1) & 1;
        for (int k = 0; k < 8; ++k) attn_item(p, tbase + (w + 64 * k) * 4, gg, hsm);
        if (b < 128) { int it = b * 2 + hb; attn_item(p, 8192 + (it >> 1) * 4, it & 1, hsm); }
      } else {
        FOR_ITEMS(4352, it) attn_item(p, (it >> 1) * 4, it & 1, hsm);
      }
      break;
    case 7: phase_ssdnorm(p); break;
    case 8: {
      GemmArgs g{}; g.A = p.Abuf; g.lda = 2048; g.B = p.Wt_out_ab; g.K = 2048; g.ntn = 8; g.ntiles = 32 * 8;
      g.xin = nullptr; g.xout = p.xcur; g.gate = mod0 + 4096;
      gemm_phase<EPI_RESID, 2>(p, g, smem);
    } break;
    case 9: phase_normmod<false>(p, p.xcur, p.norm_ffn_w, mod0, 6144, 8192); break;
    case 10: {
      GemmArgs g{}; g.A = p.Abuf; g.lda = 2048; g.B = p.Wt_gu; g.K = 2048; g.ntn = 44; g.ntiles = 34 * 44;
      g.H = (u16*)p.R1;
      gemm_phase<EPI_SWIGLU, 0>(p, g, smem);
    } break;
    case 11: {
      GemmArgs g{}; g.A = (const u16*)p.R1; g.lda = FFN; g.B = p.Wt_down; g.K = FFN; g.ntn = 8; g.ntiles = 32 * 8;
      g.xin = p.xcur; g.xout = p.xcur; g.gate = mod0 + 10240;
      gemm_phase<EPI_RESID, 2>(p, g, smem);
    } break;
    case 12: phase_normmod<false>(p, p.xcur, p.norm_mix_w + 2048, mod1, 0, 2048); break;
    case 13: {
      GemmArgs g{}; g.A = p.Abuf; g.lda = 2048; g.B = p.Wt_in_c; g.K = 2048; g.ntn = 16; g.ntiles = 32 * 16;
      g.C = p.R1; g.ldc = 4096; g.nvalid = 4096;
      gemm_phase<EPI_F32, 2>(p, g, smem);
    } break;
    case 14:
      FOR_ITEMS(NTOK, it) lru_conv_item(p, it);
      break;
    case 15: {
      GemmArgs g{}; g.A = p.Abuf; g.lda = 2048; g.B = p.Wt_ax; g.K = 128; g.ntn = 32; g.ntiles = 34 * 32;
      gemm_phase<EPI_LRU, 1>(p, g, smem);
    } break;
    case 16:
      break;
    case 17:
      FOR_ITEMS(640, it) lru_scan_item(p, it);
      break;
    case 18: {
      GemmArgs g{}; g.A = p.Abuf; g.lda = 2048; g.B = p.Wt_out_c; g.K = 2048; g.ntn = 8; g.ntiles = 32 * 8;
      g.xin = p.xcur; g.xout = p.xcur; g.gate = mod1 + 4096;
      gemm_phase<EPI_RESID, 2>(p, g, smem);
    } break;
    case 19: phase_normmod<false>(p, p.xcur, p.norm_ffn_w + 2048, mod1, 6144, 8192); break;
    case 20: {
      GemmArgs g{}; g.A = p.Abuf; g.lda = 2048; g.B = p.Wt_gu + (size_t)11264 * 2048; g.K = 2048; g.ntn = 44; g.ntiles = 34 * 44;
      g.H = (u16*)p.R1;
      gemm_phase<EPI_SWIGLU, 0>(p, g, smem);
    } break;
    case 21: {
      GemmArgs g{}; g.A = (const u16*)p.R1; g.lda = FFN; g.B = p.Wt_down + (size_t)2048 * FFN; g.K = FFN; g.ntn = 8; g.ntiles = 32 * 8;
      g.xin = p.xcur; g.xout = p.out; g.gate = mod1 + 10240;
      gemm_phase<EPI_RESID, 2>(p, g, smem);
    } break;
    default: break;
  }
}

__device__ __forceinline__ void cnt_barrier(unsigned* ctr, unsigned target) {
  asm volatile("s_waitcnt vmcnt(0)" ::: "memory");
  __syncthreads();
  if (threadIdx.x == 0) {
    __builtin_amdgcn_fence(__ATOMIC_RELEASE, "agent");
    asm volatile("s_waitcnt vmcnt(0)" ::: "memory");
    __hip_atomic_fetch_add(ctr, 1u, __ATOMIC_RELAXED, __HIP_MEMORY_SCOPE_AGENT);
    unsigned sp = 0;
    while (__hip_atomic_load(ctr, __ATOMIC_RELAXED, __HIP_MEMORY_SCOPE_AGENT) < target) {
      __builtin_amdgcn_s_sleep(2);
      if (++sp > (1u << 22)) break;
    }
    __builtin_amdgcn_fence(__ATOMIC_ACQUIRE, "agent");
    asm volatile("s_waitcnt vmcnt(0)" ::: "memory");
  }
  __syncthreads();
}

#define PH(n) run_phase(p, n, smem); if ((DUP_MASK >> n) & 1) { XSYNC(); run_phase(p, n, smem, true); }
#define XSYNC() grid.sync()
#define PHS(n) PH(n) cnt_barrier(p.bar, (unsigned)(n) * gridDim.x)
#define PHT(n, t) PH(n) cnt_barrier(p.bar, (unsigned)(t) * gridDim.x)
__global__ void __launch_bounds__(512, 2) k_all(Params p) {
  __shared__ __attribute__((aligned(1024))) char smem[2 * HALF_LDS];
  cg::grid_group grid = cg::this_grid();
  if (blockIdx.x == 0 && threadIdx.x == 0) __hip_atomic_store(p.bar, 0u, __ATOMIC_RELAXED, __HIP_MEMORY_SCOPE_AGENT);
  PH(0);
  grid.sync();
  PHS(1); PHS(2); PHS(3); PHS(4); PHS(5); PHS(6); PHS(7); PHS(8); PHS(9); PHS(10);
  PHS(11); PHS(12); PHS(13); PHS(14); PHS(15);
  PHT(17, 16); PHT(18, 17); PHT(19, 18); PHT(20, 19); PH(21);
}

extern "C" void kernel_launch(void* const* d_in, const int* in_sizes, int n_in, void* d_out, int out_size,
                              void* d_ws, size_t ws_size, hipStream_t stream) {
  static int grid_blocks = 0;
  if (!grid_blocks) {
    int dev = 0, cus = 0, per_cu = 0;
    (void)hipGetDevice(&dev);
    (void)hipDeviceGetAttribute(&cus, hipDeviceAttributeMultiprocessorCount, dev);
    (void)hipOccupancyMaxActiveBlocksPerMultiprocessor(&per_cu, k_all, 512, 0);
    if (per_cu > 1) per_cu = 1;
    if (per_cu < 1) per_cu = 1;
    grid_blocks = cus * per_cu;
  }
  Params p{};
  const float** fin = (const float**)d_in;
  p.x_prompt = fin[0]; p.x_sample = fin[1]; p.cache_k = fin[2]; p.cache_v = fin[3]; p.cache_ki = fin[4];
  p.state_ssm = fin[5]; p.state_ssm_conv = fin[6]; p.state_lru = fin[7]; p.state_lru_conv = fin[8];
  p.c_prompt = fin[9]; p.c_sample = fin[10]; p.ada_w = fin[11]; p.ada_b = fin[12]; p.norm_mix_w = fin[13];
  p.norm_ffn_w = fin[14]; p.w_in_ab = fin[15]; p.q_norm_w = fin[16]; p.k_norm_w = fin[17]; p.ssd_conv_w = fin[18];
  p.ssd_conv_b = fin[19]; p.ssd_dt_bias = fin[20]; p.ssd_a_log = fin[21]; p.ssd_d = fin[22]; p.ssd_norm_w = fin[23];
  p.w_out_ab = fin[24]; p.w_in_c = fin[25]; p.lru_conv_w = fin[26]; p.lru_conv_b = fin[27]; p.lru_w_a = fin[28];
  p.lru_b_a = fin[29]; p.lru_w_x = fin[30]; p.lru_b_x = fin[31]; p.lru_lambda = fin[32]; p.w_out_c = fin[33];
  p.ffn_w_gate = fin[34]; p.ffn_w_up = fin[35]; p.ffn_w_down = fin[36];
  p.out = (float*)d_out;
  char* ws = (char*)d_ws;
  size_t off = 0;
  auto take = [&](size_t bytes) { size_t o = off; off += (bytes + 255) & ~(size_t)255; return ws + o; };
  p.Wt_in_ab = (u16*)take((size_t)5376 * 2048 * 2);
  p.Wt_out_ab = (u16*)take((size_t)2048 * 2048 * 2);
  p.Wt_gu = (u16*)take((size_t)2 * 11264 * 2048 * 2);
  p.Wt_down = (u16*)take((size_t)2 * 2048 * 5632 * 2);
  p.Wt_in_c = (u16*)take((size_t)4096 * 2048 * 2);
  p.Wt_ax = (u16*)take((size_t)16 * 256 * 128 * 2);
  p.Wt_out_c = (u16*)take((size_t)2048 * 2048 * 2);
  p.mod = (float*)take((size_t)2 * 18 * 12288 * 4);
  p.modp = (float*)take((size_t)4 * 2 * 18 * 12288 * 4);
  p.Abuf = (u16*)take((size_t)NTOK * 2048 * 2);
  p.R1 = (float*)take((size_t)NTOK * ABN * 4);
  p.R2 = (float*)take((size_t)NTOK * 4096 * 4);
  p.xcur = (float*)take((size_t)NTOK * 2048 * 4);
  p.qb = (u16*)take((size_t)NTOK * 1024 * 2);
  p.qib = (u16*)take((size_t)NTOK * 1024 * 2);
  p.wi = (float*)take((size_t)NTOK * 16 * 4);
  p.Kb = (u16*)take((size_t)25088 * 256 * 2);
  p.Vb = (u16*)take((size_t)25088 * 256 * 2);
  p.kib = (u16*)take((size_t)25088 * 64 * 2);
  p.xs = (float*)take((size_t)NTOK * 1024 * 4);
  p.bm = (float*)take((size_t)NTOK * 256 * 4);
  p.cm = (float*)take((size_t)NTOK * 256 * 4);
  p.dt = (float*)take((size_t)NTOK * 16 * 4);
  p.cumb = (float*)take((size_t)NTOK * 16 * 4);
  p.sel = (int*)take((size_t)NTOK * 256 * 4);
  p.aggA = (float*)take((size_t)64 * 2048 * 4);
  p.aggU = (float*)take((size_t)64 * 2048 * 4);
  p.bar = (unsigned*)take((size_t)XCD_BAR_WORDS * 4);
  if (off > ws_size) fprintf(stderr, "workspace too small: need %zu have %zu\n", off, ws_size);
  void* args[] = {&p};
  hipError_t e = hipLaunchCooperativeKernel((void*)k_all, dim3(grid_blocks), dim3(512), args, 0, stream);
  if (e != hipSuccess) fprintf(stderr, "cooperative launch failed: %s (grid %d)\n", hipGetErrorString(e), grid_blocks);
}
```

```cpp
#include <hip/hip_runtime.h>
#include <hip/hip_cooperative_groups.h>
#include <cstdio>
#include <cstdint>
namespace cg = cooperative_groups;

typedef unsigned short u16;
typedef __attribute__((ext_vector_type(8))) short bf16x8;
typedef __attribute__((ext_vector_type(16))) float f32x16;
typedef __attribute__((ext_vector_type(4))) unsigned u32x4;

#ifndef MULTI_LAUNCH
#define MULTI_LAUNCH 0
#endif

#ifndef DUP_MASK
#define DUP_MASK 0
#endif
#define HALF_LDS 67584
#define FOR_ITEMS(total, it) for (int _hb = tidx_opaque() >> 8, _j = blockIdx.x, it = 2 * _j + _hb; 2 * _j < (total); _j += gridDim.x, it = 2 * _j + _hb)
constexpr int NTOK = 8704;
constexpr int ABN = 5216;
constexpr int FFN = 5632;
constexpr int NPHASE = 22;
constexpr int O_KP = 17825792, O_VP = 19922944, O_KIP = 22020096, O_SSMP = 22544384, O_SSMCP = 22806528,
              O_LRUP = 22815744, O_LRUCP = 22819840, O_KS = 22832128, O_VS = 22963200, O_KIS = 23094272,
              O_SSMS = 23127040, O_SSMCS = 25224192, O_LRUS = 25297920, O_LRUCS = 25330688;

struct Params {
  const float *x_prompt, *x_sample, *cache_k, *cache_v, *cache_ki, *state_ssm, *state_ssm_conv, *state_lru,
      *state_lru_conv, *c_prompt, *c_sample;
  const float *ada_w, *ada_b, *norm_mix_w, *norm_ffn_w, *w_in_ab, *q_norm_w, *k_norm_w, *ssd_conv_w, *ssd_conv_b,
      *ssd_dt_bias, *ssd_a_log, *ssd_d, *ssd_norm_w, *w_out_ab, *w_in_c, *lru_conv_w, *lru_conv_b, *lru_w_a,
      *lru_b_a, *lru_w_x, *lru_b_x, *lru_lambda, *w_out_c, *ffn_w_gate, *ffn_w_up, *ffn_w_down;
  float* out;
  u16 *Wt_in_ab, *Wt_out_ab, *Wt_gu, *Wt_down, *Wt_in_c, *Wt_ax, *Wt_out_c;
  float* mod;
  float* modp;
  u16* Abuf;
  float* R1;
  float* R2;
  float* xcur;
  u16 *qb, *qib;
  float* wi;
  u16 *Kb, *Vb, *kib;
  float *xs, *bm, *cm, *dt, *cumb;
  int* sel;
  float *aggA, *aggU;
  unsigned* bar;
};

typedef const __attribute__((address_space(4))) Params* cparams_t;
__device__ __forceinline__ const Params& opaque_params(const Params& p0) {
  cparams_t q = (cparams_t)__builtin_amdgcn_kernarg_segment_ptr();
  asm volatile("" : "+s"(q));
  return *(const Params*)q;
}
__device__ __forceinline__ int tidx_opaque() {
  int t = threadIdx.x;
  asm volatile("" : "+v"(t));
  return t;
}
__device__ __forceinline__ u16 f2bf(float f) {
  unsigned u = __float_as_uint(f);
  u += 0x7fffu + ((u >> 16) & 1u);
  return (u16)(u >> 16);
}
__device__ __forceinline__ unsigned pack2(float a, float b) { return (unsigned)f2bf(a) | ((unsigned)f2bf(b) << 16); }
__device__ __forceinline__ float bf2f(u16 h) { return __uint_as_float((unsigned)h << 16); }
__device__ __forceinline__ float bflo(unsigned u) { return __uint_as_float(u << 16); }
__device__ __forceinline__ float bfhi(unsigned u) { return __uint_as_float(u & 0xffff0000u); }
__device__ __forceinline__ float wave_sum(float v) {
#pragma unroll
  for (int o = 32; o > 0; o >>= 1) v += __shfl_xor(v, o);
  return v;
}
__device__ __forceinline__ float wave_max(float v) {
#pragma unroll
  for (int o = 32; o > 0; o >>= 1) v = fmaxf(v, __shfl_xor(v, o));
  return v;
}
__device__ __forceinline__ float siluf_(float x) { return x / (1.f + __expf(-x)); }
__device__ __forceinline__ void tok_info(int tok, int& seq, int& t, int& pos, int& T) {
  if (tok < 8192) { seq = tok >> 12; t = tok & 4095; pos = t; T = 4096; }
  else { int r = tok - 8192; seq = 2 + (r >> 5); t = r & 31; pos = 1024 + t; T = 32; }
}
__device__ __forceinline__ int tok_seq(int tok) { return tok < 8192 ? (tok >> 12) : 2 + ((tok - 8192) >> 5); }
__device__ __forceinline__ int kv_base(int seq) { return seq < 2 ? seq * 4096 : 8192 + (seq - 2) * 1056; }
__device__ __forceinline__ const float* xin_row(const Params& p, int tok) {
  return tok < 8192 ? p.x_prompt + (size_t)tok * 2048 : p.x_sample + (size_t)(tok - 8192) * 2048;
}
__device__ __forceinline__ void rope_cs(float fpos, int i, float inv_half, float& c, float& s) {
  float inv = exp2f(-(float)i * inv_half * 13.287712379549449f);
  float ang = fpos * inv;
  float rev = ang * 0.15915494309189535f;
  rev -= floorf(rev);
  c = __builtin_amdgcn_cosf(rev);
  s = __builtin_amdgcn_sinf(rev);
}
__device__ __forceinline__ f32x16 zero16() {
  f32x16 z;
#pragma unroll
  for (int i = 0; i < 16; ++i) z[i] = 0.f;
  return z;
}

__device__ __forceinline__ void ada_item(const Params& p, int item, float* sm) {
  const int kc = item & 3, rest = item >> 2;
  const int l = rest / 192, slab = rest % 192;
  const int tid = (tidx_opaque() & 255), cl = tid & 15, kg = tid >> 4;
  float acc[18][4];
#pragma unroll
  for (int s = 0; s < 18; ++s) { acc[s][0] = acc[s][1] = acc[s][2] = acc[s][3] = 0.f; }
  const float* W = p.ada_w + (size_t)l * 2048 * 12288 + (size_t)(kc * 512) * 12288 + slab * 64 + cl * 4;
  for (int i = tid; i < 18 * 512; i += 256) {
    int s = i >> 9, k = i & 511;
    float c = s < 2 ? p.c_prompt[s * 2048 + kc * 512 + k] : p.c_sample[(s - 2) * 2048 + kc * 512 + k];
    sm[i] = c / (1.f + expf(-c));
  }
  __syncthreads();
#pragma unroll 8
  for (int kk = kg; kk < 512; kk += 16) {
    float4 w = *(const float4*)(W + (size_t)kk * 12288);
#pragma unroll
    for (int s = 0; s < 18; ++s) {
      float c = sm[s * 512 + kk];
      acc[s][0] += c * w.x; acc[s][1] += c * w.y; acc[s][2] += c * w.z; acc[s][3] += c * w.w;
    }
  }
#pragma unroll
  for (int s = 0; s < 18; ++s)
#pragma unroll
    for (int j = 0; j < 4; ++j) {
      float v = acc[s][j];
      v += __shfl_xor(v, 16);
      v += __shfl_xor(v, 32);
      acc[s][j] = v;
    }
  __syncthreads();
  const int wave = tid >> 6, lane = tid & 63;
  if (lane < 16) {
#pragma unroll
    for (int s = 0; s < 18; ++s)
#pragma unroll
      for (int j = 0; j < 4; ++j) sm[(wave * 72 + s * 4 + j) * 16 + lane] = acc[s][j];
  }
  __syncthreads();
  for (int i = tid; i < 1152; i += 256) {
    int sj = i >> 4, c = i & 15;
    float v = sm[(0 * 72 + sj) * 16 + c] + sm[(1 * 72 + sj) * 16 + c] + sm[(2 * 72 + sj) * 16 + c] + sm[(3 * 72 + sj) * 16 + c];
    int s = sj >> 2, j = sj & 3;
    int col = slab * 64 + c * 4 + j;
    p.modp[(size_t)((kc * 2 + l) * 18 + s) * 12288 + col] = v;
  }
  __syncthreads();
}

__device__ __forceinline__ void conv_tile(const float* src, int ldn, int K, int Nvalid, int Nstore, int kt, int nt, u16* dst, int mode, float* sm) {
  const int tid = (tidx_opaque() & 255);
  float4 v[16];
#pragma unroll
  for (int i = 0; i < 16; ++i) {
    int idx = tid + 256 * i;
    int kk = idx >> 6, c4 = idx & 63;
    int n = nt * 256 + c4 * 4;
    v[i] = make_float4(0.f, 0.f, 0.f, 0.f);
    if (n < Nvalid) v[i] = *(const float4*)(src + (size_t)(kt * 64 + kk) * ldn + n);
  }
#pragma unroll
  for (int i = 0; i < 16; ++i) {
    int idx = tid + 256 * i;
    int kk = idx >> 6, c4 = idx & 63;
    float* d = sm + kk * 257 + c4 * 4;
    d[0] = v[i].x; d[1] = v[i].y; d[2] = v[i].z; d[3] = v[i].w;
  }
  __syncthreads();
#pragma unroll
  for (int i = 0; i < 8; ++i) {
    int idx = tid + 256 * i;
    int nn = idx >> 3, kc = idx & 7;
    const float* s = sm + (kc * 8) * 257 + nn;
    uint4 o;
    o.x = pack2(s[0 * 257], s[1 * 257]);
    o.y = pack2(s[2 * 257], s[3 * 257]);
    o.z = pack2(s[4 * 257], s[5 * 257]);
    o.w = pack2(s[6 * 257], s[7 * 257]);
    int n = nt * 256 + nn;
    int r = (mode == 0) ? n : (64 * (n >> 5) + (n & 31) + (mode == 2 ? 32 : 0));
    if (n < Nstore) *(uint4*)(dst + (size_t)r * K + kt * 64 + kc * 8) = o;
  }
  __syncthreads();
}

__device__ __forceinline__ void conv_item(const Params& p, int i, float* sm) {
  if (i < 672) { conv_tile(p.w_in_ab, 5216, 2048, 5216, 5376, i / 21, i % 21, p.Wt_in_ab, 0, sm); return; }
  i -= 672;
  if (i < 256) { conv_tile(p.w_out_ab, 2048, 2048, 2048, 2048, i >> 3, i & 7, p.Wt_out_ab, 0, sm); return; }
  i -= 256;
  if (i < 1408) { int l = i / 704, r = i % 704;
    conv_tile(p.ffn_w_gate + (size_t)l * 2048 * 5632, 5632, 2048, 5632, 5632, r / 22, r % 22, p.Wt_gu + (size_t)l * 11264 * 2048, 1, sm); return; }
  i -= 1408;
  if (i < 1408) { int l = i / 704, r = i % 704;
    conv_tile(p.ffn_w_up + (size_t)l * 2048 * 5632, 5632, 2048, 5632, 5632, r / 22, r % 22, p.Wt_gu + (size_t)l * 11264 * 2048, 2, sm); return; }
  i -= 1408;
  if (i < 1408) { int l = i / 704, r = i % 704;
    conv_tile(p.ffn_w_down + (size_t)l * 5632 * 2048, 2048, 5632, 2048, 2048, r >> 3, r & 7, p.Wt_down + (size_t)l * 2048 * 5632, 0, sm); return; }
  i -= 1408;
  if (i < 512) { conv_tile(p.w_in_c, 4096, 2048, 4096, 4096, i >> 4, i & 15, p.Wt_in_c, 0, sm); return; }
  i -= 512;
  if (i < 256) { conv_tile(p.w_out_c, 2048, 2048, 2048, 2048, i >> 3, i & 7, p.Wt_out_c, 0, sm); return; }
  i -= 256;
  if (i < 32) { int kb = i >> 1, kt = i & 1;
    conv_tile(p.lru_w_a + kb * 16384, 128, 128, 128, 128, kt, 0, p.Wt_ax + kb * 32768, 1, sm); return; }
  i -= 32;
  { int kb = i >> 1, kt = i & 1;
    conv_tile(p.lru_w_x + kb * 16384, 128, 128, 128, 128, kt, 0, p.Wt_ax + kb * 32768, 2, sm); }
}

__device__ __forceinline__ void cache_item(const Params& p, int i) {
  const int tid = (tidx_opaque() & 255);
  const float* src; u16* dst; int rowlen;
  if (i < 2048) { src = p.cache_k; dst = p.Kb; rowlen = 256; }
  else if (i < 4096) { i -= 2048; src = p.cache_v; dst = p.Vb; rowlen = 256; }
  else { i -= 4096; src = p.cache_ki; dst = p.kib; rowlen = 64; }
  int e = i * 2048 + tid * 8;
  int row = e / rowlen, col = e % rowlen;
  int b = row >> 10, pos = row & 1023;
  float4 v0 = *(const float4*)(src + e), v1 = *(const float4*)(src + e + 4);
  uint4 o;
  o.x = pack2(v0.x, v0.y); o.y = pack2(v0.z, v0.w); o.z = pack2(v1.x, v1.y); o.w = pack2(v1.z, v1.w);
  *(uint4*)(dst + (size_t)(8192 + b * 1056 + pos) * rowlen + col) = o;
}

__device__ __forceinline__ float4 ld4sum(const float* base, size_t stride, const float* bias) {
  float4 a = *(const float4*)base, b = *(const float4*)(base + stride), c = *(const float4*)(base + 2 * stride),
         d = *(const float4*)(base + 3 * stride), e = *(const float4*)bias;
  return make_float4(a.x + b.x + c.x + d.x + e.x, a.y + b.y + c.y + d.y + e.y, a.z + b.z + c.z + d.z + e.z, a.w + b.w + c.w + d.w + e.w);
}
template <bool PARTIAL>
__device__ __forceinline__ void phase_normmod(const Params& p, const float* xsrc, const float* nw, const float* modl, int sh_off, int sc_off) {
  const int lane = (tidx_opaque() & 255) & 63, wave = (tidx_opaque() & 255) >> 6;
  FOR_ITEMS(NTOK / 4 + (PARTIAL ? 432 : 0), it) {
    if (PARTIAL && it >= NTOK / 4) {
      int e = ((it - NTOK / 4) * 256 + (tidx_opaque() & 255)) * 4;
      int col = e % 12288, l = e / (18 * 12288);
      *(float4*)(p.mod + e) = ld4sum(p.modp + e, (size_t)2 * 18 * 12288, p.ada_b + l * 12288 + col);
      continue;
    }
    int tok = it * 4 + wave;
    const float* xr = xsrc ? xsrc + (size_t)tok * 2048 : xin_row(p, tok);
    const float* md = modl + (size_t)tok_seq(tok) * 12288;
    float4 v[8], wv[8], scv[8], shv[8];
    float ss = 0.f;
#pragma unroll
    for (int i = 0; i < 8; ++i) v[i] = *(const float4*)(xr + i * 256 + lane * 4);
#pragma unroll
    for (int i = 0; i < 8; ++i) {
      int c = i * 256 + lane * 4;
      wv[i] = *(const float4*)(nw + c);
      if (PARTIAL) {
        scv[i] = ld4sum(md + sc_off + c, (size_t)2 * 18 * 12288, p.ada_b + sc_off + c);
        shv[i] = ld4sum(md + sh_off + c, (size_t)2 * 18 * 12288, p.ada_b + sh_off + c);
      } else {
        scv[i] = *(const float4*)(md + sc_off + c);
        shv[i] = *(const float4*)(md + sh_off + c);
      }
    }
#pragma unroll
    for (int i = 0; i < 8; ++i) ss += v[i].x * v[i].x + v[i].y * v[i].y + v[i].z * v[i].z + v[i].w * v[i].w;
    ss = wave_sum(ss);
    float rn = rsqrtf(ss * (1.f / 2048.f) + 1e-6f);
#pragma unroll
    for (int i = 0; i < 8; ++i) {
      int c = i * 256 + lane * 4;
      const float4 w = wv[i], sc = scv[i], sh = shv[i];
      float a0 = v[i].x * rn * w.x * (1.f + sc.x) + sh.x;
      float a1 = v[i].y * rn * w.y * (1.f + sc.y) + sh.y;
      float a2 = v[i].z * rn * w.z * (1.f + sc.z) + sh.z;
      float a3 = v[i].w * rn * w.w * (1.f + sc.w) + sh.w;
      uint2 o; o.x = pack2(a0, a1); o.y = pack2(a2, a3);
      *(uint2*)(p.Abuf + (size_t)tok * 2048 + c) = o;
    }
  }
}

enum { EPI_F32 = 0, EPI_RESID = 1, EPI_SWIGLU = 2, EPI_LRU = 3 };
struct GemmArgs {
  const u16* A; int lda; const u16* B; int K; int ntn; int ntiles;
  float* C; int ldc; int nvalid;
  const float* xin; float* xout; const float* gate;
  u16* H;
};
typedef __attribute__((ext_vector_type(4))) float f32x4;
__device__ __forceinline__ int lds_byte(int r, int c) {
  int st = (r >> 4) * 2 + (c >> 5), ob = (r & 15) * 64 + (c & 31) * 2;
  return st * 1024 + (ob ^ (((ob >> 9) & 1) << 5));
}
__device__ __forceinline__ void stage_rc(int b, int& R, int& C) {
  int st = b >> 10, sb = b & 1023, swz = sb ^ (((sb >> 9) & 1) << 5);
  R = (st >> 1) * 16 + swz / 64;
  C = (st & 1) * 32 + (swz % 64) / 2;
}
#define WAIT_V0() asm volatile("s_waitcnt vmcnt(0)" ::: "memory")
typedef const __attribute__((address_space(1))) unsigned* gptr_t;
typedef __attribute__((address_space(3))) unsigned* lptr_t;

template <int EPI, int CFG>
__device__ __forceinline__ void gemm_phase(const Params& p, const GemmArgs& g, char* smem) {
  constexpr int WC = (CFG == 1) ? 2 : 4;
  constexpr int NF = 4;
  constexpr int MF = (CFG == 0) ? 8 : (CFG == 1 ? 4 : 9);
  constexpr int BM = (CFG == 2) ? 272 : 256;
  constexpr int BN = WC * NF * 16;
  constexpr int NSUBA = BM / 16 * 2;
  constexpr int OFF_B = NSUBA * 1024;
  constexpr int STAGE_B = OFF_B + 32768;
  constexpr int GLA = (NSUBA + 7) / 8;
  constexpr int GLB = BN * 128 / 8192;
  constexpr int WROWS = (CFG == 2) ? 144 : MF * 16;
  constexpr int ntm = (CFG == 2) ? 32 : 34;
  const int tid = tidx_opaque(), wid = tid >> 6, lane = tid & 63, wr = wid / WC, wc = wid % WC, fr = lane & 15, fq = lane >> 4;
  const bool mlast = (CFG != 2) || (wr == 0);
  int sR[GLA], sC[GLA];
#pragma unroll
  for (int i = 0; i < GLA; ++i) stage_rc(wid * 1024 + i * 8192 + lane * 16, sR[i], sC[i]);
  const int nk = g.K >> 6;
  const int G = gridDim.x;
  const int bperm = (blockIdx.x & 7) * (G >> 3) + (blockIdx.x >> 3);
#define TILE_COORDS(lin_, mt_, nt_, Ab_, Bb_)                                                                         \
  do {                                                                                                                \
    if (EPI == EPI_LRU) {                                                                                             \
      mt_ = (lin_) >> 5; nt_ = (lin_) & 31;                                                                           \
      Ab_ = g.A + (size_t)mt_ * 256 * g.lda + (nt_ >> 1) * 128;                                                       \
      Bb_ = g.B + (size_t)nt_ * 128 * 128;                                                                            \
    } else {                                                                                                          \
      const int nig_ = 8 * g.ntn, gid_ = (lin_) / nig_, fm_ = gid_ * 8, gsz_ = min(ntm - fm_, 8), rem_ = (lin_) - gid_ * nig_; \
      mt_ = fm_ + rem_ % gsz_; nt_ = rem_ / gsz_;                                                                     \
      Ab_ = g.A + (size_t)mt_ * BM * g.lda;                                                                           \
      Bb_ = g.B + (size_t)nt_ * BN * g.K;                                                                             \
    }                                                                                                                 \
  } while (0)
#define GLDS_STAGE_P(buf, kt, Ap_, Bp_)                                                                              \
  do {                                                                                                                \
    _Pragma("unroll") for (int i = 0; i < GLA; ++i)                                                                   \
        if (i * 8 + 7 < NSUBA || wid + i * 8 < NSUBA)                                                                 \
          __builtin_amdgcn_global_load_lds((gptr_t)((Ap_) + (size_t)sR[i] * g.lda + (kt) * 64 + sC[i]),               \
                                           (lptr_t)(smem + (buf) * STAGE_B + wid * 1024 + i * 8192), 16, 0, 0);        \
    _Pragma("unroll") for (int i = 0; i < GLB; ++i)                                                                   \
        __builtin_amdgcn_global_load_lds((gptr_t)((Bp_) + (size_t)sR[i] * g.K + (kt) * 64 + sC[i]),                   \
                                         (lptr_t)(smem + (buf) * STAGE_B + OFF_B + wid * 1024 + i * 8192), 16, 0, 0);  \
  } while (0)
#define GLDS_STAGE(buf, kt) GLDS_STAGE_P(buf, kt, Ab, Bb)
  constexpr bool SEAM = (EPI != EPI_LRU);
  int mt = 0, nt = 0;
  const u16 *Ab = g.A, *Bb = g.B;
  if (bperm < g.ntiles) { TILE_COORDS(bperm, mt, nt, Ab, Bb); if (SEAM) GLDS_STAGE(0, 0); }
  for (int base = 0; base < g.ntiles; base += G) {
    const int lin = base + bperm;
    if (lin >= g.ntiles) continue;
    const int brow = mt * BM, bcol = nt * BN;
    f32x4 acc[MF][NF];
#pragma unroll
    for (int m = 0; m < MF; ++m)
#pragma unroll
      for (int n = 0; n < NF; ++n) { acc[m][n][0] = 0.f; acc[m][n][1] = 0.f; acc[m][n][2] = 0.f; acc[m][n][3] = 0.f; }
    if (!SEAM) GLDS_STAGE(0, 0);
    WAIT_V0();
    __syncthreads();
#pragma unroll 1
    for (int t = 0; t < nk; ++t) {
      const int cur = t & 1;
      if (t + 1 < nk) GLDS_STAGE(cur ^ 1, t + 1);
      const char* sa = smem + cur * STAGE_B;
      const char* sb = sa + OFF_B;
#pragma unroll
      for (int ks = 0; ks < 2; ++ks) {
        bf16x8 Bf[NF];
#pragma unroll
        for (int n = 0; n < NF; ++n) Bf[n] = *(const bf16x8*)(sb + lds_byte(wc * (NF * 16) + n * 16 + fr, ks * 32 + fq * 8));
        __builtin_amdgcn_s_setprio(1);
        if (CFG == 2) {
#pragma unroll
          for (int mb = 0; mb < 9; mb += 3) {
            bf16x8 At[3];
#pragma unroll
            for (int m = 0; m < 3; ++m)
              if (mb + m < 8 || mlast) At[m] = *(const bf16x8*)(sa + lds_byte(wr * WROWS + (mb + m) * 16 + fr, ks * 32 + fq * 8));
#pragma unroll
            for (int m = 0; m < 3; ++m)
              if (mb + m < 8 || mlast) {
#pragma unroll
                for (int n = 0; n < NF; ++n) acc[mb + m][n] = __builtin_amdgcn_mfma_f32_16x16x32_bf16(At[m], Bf[n], acc[mb + m][n], 0, 0, 0);
              }
          }
        } else {
          bf16x8 At[MF];
#pragma unroll
          for (int m = 0; m < MF; ++m) At[m] = *(const bf16x8*)(sa + lds_byte(wr * WROWS + m * 16 + fr, ks * 32 + fq * 8));
#pragma unroll
          for (int m = 0; m < MF; ++m)
#pragma unroll
            for (int n = 0; n < NF; ++n) acc[m][n] = __builtin_amdgcn_mfma_f32_16x16x32_bf16(At[m], Bf[n], acc[m][n], 0, 0, 0);
        }
        __builtin_amdgcn_s_setprio(0);
      }
      WAIT_V0();
      __syncthreads();
    }
    const int nt_cur = nt, mt_cur = mt;
    {
      const int nlin = lin + G;
      if (nlin < g.ntiles) { TILE_COORDS(nlin, mt, nt, Ab, Bb); if (SEAM) GLDS_STAGE(0, 0); }
    }
    const int rb = brow + wr * WROWS + fq * 4;
    const int cb = bcol + wc * (NF * 16) + fr;
    if (EPI == EPI_F32) {
#pragma unroll
      for (int n = 0; n < NF; ++n) {
        int col = cb + n * 16;
        if (col < g.nvalid) {
#pragma unroll
          for (int m = 0; m < MF; ++m)
            if (m < 8 || mlast) {
#pragma unroll
              for (int j = 0; j < 4; ++j) g.C[(size_t)(rb + m * 16 + j) * g.ldc + col] = acc[m][n][j];
            }
        }
      }
    } else if (EPI == EPI_RESID) {
#pragma unroll
      for (int m = 0; m < MF; ++m)
        if (m < 8 || mlast) {
          float xv[4][NF], gv[4][NF];
#pragma unroll
          for (int j = 0; j < 4; ++j) {
            int row = rb + m * 16 + j;
            const float* __restrict__ gp = g.gate + (size_t)tok_seq(row) * 12288;
            const float* __restrict__ xi = g.xin ? g.xin + (size_t)row * 2048 : xin_row(p, row);
#pragma unroll
            for (int n = 0; n < NF; ++n) { xv[j][n] = xi[cb + n * 16]; gv[j][n] = gp[cb + n * 16]; }
          }
#pragma unroll
          for (int j = 0; j < 4; ++j) {
            float* xo = g.xout + (size_t)(rb + m * 16 + j) * 2048;
#pragma unroll
            for (int n = 0; n < NF; ++n) xo[cb + n * 16] = xv[j][n] + gv[j][n] * acc[m][n][j];
          }
        }
    } else if (EPI == EPI_SWIGLU) {
      const int f0 = ((bcol + wc * 64) >> 1) + fr;
#pragma unroll
      for (int m = 0; m < MF; ++m)
#pragma unroll
        for (int j = 0; j < 4; ++j) {
          int row = rb + m * 16 + j;
#pragma unroll
          for (int n = 0; n < 2; ++n) g.H[(size_t)row * FFN + f0 + n * 16] = f2bf(siluf_(acc[m][n][j]) * acc[m][n + 2][j]);
        }
    } else {
      float* abuf = p.R2;
      float* ubuf = p.R2 + (size_t)NTOK * 2048;
      float xcv[2][MF][4];
#pragma unroll
      for (int n = 0; n < 2; ++n)
#pragma unroll
        for (int m = 0; m < MF; ++m)
#pragma unroll
          for (int j = 0; j < 4; ++j) xcv[n][m][j] = ubuf[(size_t)(rb + m * 16 + j) * 2048 + nt_cur * 64 + wc * 32 + n * 16 + fr];
      float aggA_w[2], aggU_w[2];
#pragma unroll
      for (int n = 0; n < 2; ++n) {
        const int ch = nt_cur * 64 + wc * 32 + n * 16 + fr;
        const float ba = p.lru_b_a[ch], bx = p.lru_b_x[ch];
        const float sp = log1pf(expf(-p.lru_lambda[ch]));
        float Aw = 1.f, Uw = 0.f;
#pragma unroll
        for (int m = 0; m < MF; ++m) {
          float Al = 1.f, Ul = 0.f;
#pragma unroll
          for (int j = 0; j < 4; ++j) {
            int row = rb + m * 16 + j;
            float rr = 1.f / (1.f + expf(-(acc[m][n][j] + ba)));
            float ii = 1.f / (1.f + expf(-(acc[m][n + 2][j] + bx)));
            float la = -8.f * rr * sp;
            float av = expf(la);
            float mult = sqrtf(-expm1f(2.f * la));
            float uv = mult * ii * xcv[n][m][j];
            size_t o = (size_t)row * 2048 + ch;
            abuf[o] = av;
            ubuf[o] = uv;
            Ul = av * Ul + uv; Al *= av;
          }
          {
            float Ap = __shfl_xor(Al, 16), Up = __shfl_xor(Ul, 16);
            if ((fq & 1) == 0) { Ul = Ap * Ul + Up; Al = Ap * Al; } else { Ul = Al * Up + Ul; Al = Al * Ap; }
            Ap = __shfl_xor(Al, 32); Up = __shfl_xor(Ul, 32);
            if ((fq & 2) == 0) { Ul = Ap * Ul + Up; Al = Ap * Al; } else { Ul = Al * Up + Ul; Al = Al * Ap; }
          }
          Uw = Al * Uw + Ul; Aw = Al * Aw;
        }
        aggA_w[n] = Aw; aggU_w[n] = Uw;
      }
      {
        float* sg = (float*)smem;
        if (fq == 0) {
#pragma unroll
          for (int n = 0; n < 2; ++n) { float* d = sg + ((((wr * 2 + wc) * 2 + n) * 16 + fr) << 1); d[0] = aggA_w[n]; d[1] = aggU_w[n]; }
        }
        __syncthreads();
        if (mt_cur < 32 && tid < 128) {
          const int c2 = tid >> 6, rest = tid & 63, wc2 = rest >> 5, n2 = (rest >> 4) & 1, fr2 = rest & 15;
          const float* s0 = sg + (((((2 * c2) * 2 + wc2) * 2 + n2) * 16 + fr2) << 1);
          const float* s1 = sg + (((((2 * c2 + 1) * 2 + wc2) * 2 + n2) * 16 + fr2) << 1);
          const int ch2 = nt_cur * 64 + wc2 * 32 + n2 * 16 + fr2;
          const int chunk = mt_cur * 2 + c2;
          p.aggA[chunk * 2048 + ch2] = s1[0] * s0[0];
          p.aggU[chunk * 2048 + ch2] = s1[0] * s0[1] + s1[1];
        }
        __syncthreads();
      }
    }
  }
}

__device__ __forceinline__ void post_proj_item(const Params& p, int item) {
  const int tid = (tidx_opaque() & 255), lane = tid & 63, wave = tid >> 6;
  const int tokb = item * 2;
  int seq, t0, pos0, T;
  tok_info(tokb, seq, t0, pos0, T);
  const float* __restrict__ prb = p.R1 + (size_t)tokb * ABN;
  float q1[2][2], q2[2][2], kv1[2], kv2[2], i1[2][2], i2[2][2], m1[2], m2[2], u[2][6][4], cw[6][5];
#pragma unroll
  for (int k = 0; k < 2; ++k) {
    const float* __restrict__ pr = prb + k * ABN;
    const int t = t0 + k;
#pragma unroll
    for (int rd = 0; rd < 2; ++rd) { int h = rd * 4 + wave; q1[k][rd] = pr[h * 128 + lane]; q2[k][rd] = pr[h * 128 + 64 + lane]; }
    kv1[k] = pr[1024 + wave * 128 + lane]; kv2[k] = pr[1024 + wave * 128 + 64 + lane];
#pragma unroll
    for (int rd = 0; rd < 2; ++rd) { int pair = tid + 256 * rd; int h = pair >> 5, i = pair & 31; i1[k][rd] = pr[1536 + h * 64 + i]; i2[k][rd] = pr[1536 + h * 64 + 32 + i]; }
    m1[k] = 0.f; m2[k] = 0.f;
    if (tid < 32) { m1[k] = pr[2560 + tid]; m2[k] = pr[2560 + 32 + tid]; }
    else if (tid < 48) m1[k] = pr[2624 + (tid - 32)];
    else if (tid >= 64 && tid < 80) m1[k] = pr[5200 + (tid - 64)] + p.ssd_dt_bias[tid - 64];
#pragma unroll
    for (int i = 0; i < 6; ++i) {
      int c = tid + 256 * i;
#pragma unroll
      for (int d = 0; d < 4; ++d) {
        int tt = t - d;
        if (tt >= 0) u[k][i][d] = pr[3664 + c - d * ABN];
        else u[k][i][d] = seq < 2 ? 0.f : p.state_ssm_conv[((seq - 2) * 3 + (3 + tt)) * 1536 + c];
      }
    }
  }
#pragma unroll
  for (int i = 0; i < 6; ++i) {
    int c = tid + 256 * i;
    cw[i][0] = p.ssd_conv_w[c]; cw[i][1] = p.ssd_conv_w[1536 + c]; cw[i][2] = p.ssd_conv_w[2 * 1536 + c];
    cw[i][3] = p.ssd_conv_w[3 * 1536 + c]; cw[i][4] = p.ssd_conv_b[c];
  }
  const float qw1 = p.q_norm_w[lane], qw2 = p.q_norm_w[64 + lane], kw1 = p.k_norm_w[lane], kw2 = p.k_norm_w[64 + lane];
#pragma unroll
  for (int k = 0; k < 2; ++k) {
    const int tok = tokb + k, t = t0 + k, pos = pos0 + k;
    const int kvrow = kv_base(seq) + pos;
    const float fpos = (float)pos;
    float* kout = tok < 8192 ? p.out + O_KP + (size_t)tok * 256 : p.out + O_KS + (size_t)(tok - 8192) * 256;
    float* vout = tok < 8192 ? p.out + O_VP + (size_t)tok * 256 : p.out + O_VS + (size_t)(tok - 8192) * 256;
    float* kiout = tok < 8192 ? p.out + O_KIP + (size_t)tok * 64 : p.out + O_KIS + (size_t)(tok - 8192) * 64;
    float c64, s64;
    rope_cs(fpos, lane, 1.f / 64.f, c64, s64);
#pragma unroll
    for (int rd = 0; rd < 2; ++rd) {
      int h = rd * 4 + wave;
      float x1 = q1[k][rd], x2 = q2[k][rd];
      float ss = wave_sum(x1 * x1 + x2 * x2);
      float rn = rsqrtf(ss * (1.f / 128.f) + 1e-6f);
      x1 *= rn * qw1;
      x2 *= rn * qw2;
      u16* q = p.qb + ((size_t)tok * 8 + h) * 128;
      q[lane] = f2bf(x1 * c64 - x2 * s64);
      q[64 + lane] = f2bf(x1 * s64 + x2 * c64);
    }
    if (wave < 2) {
      int h = wave;
      float x1 = kv1[k], x2 = kv2[k];
      float ss = wave_sum(x1 * x1 + x2 * x2);
      float rn = rsqrtf(ss * (1.f / 128.f) + 1e-6f);
      x1 *= rn * kw1;
      x2 *= rn * kw2;
      float o1 = x1 * c64 - x2 * s64, o2 = x1 * s64 + x2 * c64;
      kout[h * 128 + lane] = o1; kout[h * 128 + 64 + lane] = o2;
      u16* kb = p.Kb + (size_t)kvrow * 256 + h * 128;
      kb[lane] = f2bf(o1); kb[64 + lane] = f2bf(o2);
    } else {
      int h = wave - 2;
      vout[h * 128 + lane] = kv1[k]; vout[h * 128 + 64 + lane] = kv2[k];
      u16* vb = p.Vb + (size_t)kvrow * 256 + h * 128;
      vb[lane] = f2bf(kv1[k]); vb[64 + lane] = f2bf(kv2[k]);
    }
#pragma unroll
    for (int rd = 0; rd < 2; ++rd) {
      int pair = tid + 256 * rd;
      int h = pair >> 5, i = pair & 31;
      float c, s;
      rope_cs(fpos, i, 1.f / 32.f, c, s);
      u16* q = p.qib + ((size_t)tok * 16 + h) * 64;
      q[i] = f2bf(i1[k][rd] * c - i2[k][rd] * s);
      q[32 + i] = f2bf(i1[k][rd] * s + i2[k][rd] * c);
    }
    if (tid < 32) {
      float c, s;
      rope_cs(fpos, tid, 1.f / 32.f, c, s);
      float o1 = m1[k] * c - m2[k] * s, o2 = m1[k] * s + m2[k] * c;
      kiout[tid] = o1; kiout[32 + tid] = o2;
      u16* kb = p.kib + (size_t)kvrow * 64;
      kb[tid] = f2bf(o1); kb[32 + tid] = f2bf(o2);
    } else if (tid < 48) {
      p.wi[tok * 16 + (tid - 32)] = m1[k] * (0.25f * 0.125f);
    } else if (tid >= 64 && tid < 80) {
      p.dt[tok * 16 + (tid - 64)] = m1[k] > 20.f ? m1[k] : log1pf(expf(m1[k]));
    }
#pragma unroll
    for (int i = 0; i < 6; ++i) {
      int c = tid + 256 * i;
      float o = cw[i][4] + cw[i][3] * u[k][i][0] + cw[i][2] * u[k][i][1] + cw[i][1] * u[k][i][2] + cw[i][0] * u[k][i][3];
      o = siluf_(o);
      if (c < 1024) p.xs[(size_t)tok * 1024 + c] = o;
      else if (c < 1280) p.bm[(size_t)tok * 256 + (c - 1024)] = o;
      else p.cm[(size_t)tok * 256 + (c - 1280)] = o;
      if (t >= T - 3) {
        int j = t - (T - 3);
        float* dst = seq < 2 ? p.out + O_SSMCP + (seq * 3 + j) * 1536 : p.out + O_SSMCS + ((seq - 2) * 3 + j) * 1536;
        dst[c] = u[k][i][0];
      }
    }
  }
}

__device__ __forceinline__ void idx_item(const Params& p, int item) {
  const int tid = (tidx_opaque() & 255), lane = tid & 63, wave = tid >> 6;
  const int tg = item >> 2, kq = item & 3;
  const int tok0 = tg * 16;
  int seq, t, pos, T;
  tok_info(tok0, seq, t, pos, T);
  const int nkeys = seq < 2 ? ((t >> 6) + 1) * 64 : 1056;
  const int kbeg = kq * 1024;
  const int kend = min(nkeys, kbeg + 1024);
  if (kbeg >= kend) return;
  const int tokw = tok0 + wave * 4;
  const int r = lane & 31, hh = lane >> 5;
  const int tk = (r >> 2) & 1, hd = (r & 3) + 4 * (r >> 3);
  bf16x8 a[2][4];
  float wv[2][16];
#pragma unroll
  for (int pr = 0; pr < 2; ++pr) {
#pragma unroll
    for (int ks = 0; ks < 4; ++ks)
      a[pr][ks] = *(const bf16x8*)(p.qib + ((size_t)(tokw + pr * 2 + tk) * 16 + hd) * 64 + ks * 16 + hh * 8);
    const float4* wp = (const float4*)(p.wi + (tokw + pr * 2 + hh) * 16);
#pragma unroll
    for (int q = 0; q < 4; ++q) { float4 w = wp[q]; wv[pr][q * 4] = w.x; wv[pr][q * 4 + 1] = w.y; wv[pr][q * 4 + 2] = w.z; wv[pr][q * 4 + 3] = w.w; }
  }
  const int kvb = kv_base(seq);
  float* score = p.R2;
  bf16x8 b[4];
#pragma unroll
  for (int ks = 0; ks < 4; ++ks) b[ks] = *(const bf16x8*)(p.kib + (size_t)(kvb + kbeg + r) * 64 + ks * 16 + hh * 8);
  for (int k0 = kbeg; k0 < kend; k0 += 32) {
    bf16x8 bn[4];
    const int kn = (k0 + 32 < kend) ? k0 + 32 : k0;
#pragma unroll
    for (int ks = 0; ks < 4; ++ks) bn[ks] = *(const bf16x8*)(p.kib + (size_t)(kvb + kn + r) * 64 + ks * 16 + hh * 8);
#pragma unroll
    for (int pr = 0; pr < 2; ++pr) {
      f32x16 acc = zero16();
#pragma unroll
      for (int ks = 0; ks < 4; ++ks) acc = __builtin_amdgcn_mfma_f32_32x32x16_bf16(a[pr][ks], b[ks], acc, 0, 0, 0);
      float sc = 0.f;
#pragma unroll
      for (int q = 0; q < 16; ++q) sc += wv[pr][q] * fmaxf(acc[q], 0.f);
      __builtin_nontemporal_store(sc, score + (size_t)(tokw + pr * 2 + hh) * 4096 + k0 + r);
    }
#pragma unroll
    for (int ks = 0; ks < 4; ++ks) b[ks] = bn[ks];
  }
}

__device__ __forceinline__ void ssd_decode(int it, int& seq, int& tok0, int& L, int& h) {
  if (it < 2048) { seq = it >> 10; int c = (it >> 4) & 63; h = it & 15; L = 64; tok0 = seq * 4096 + c * 64; }
  else { int r = it - 2048; int sq = r >> 4; h = r & 15; seq = 2 + sq; L = 32; tok0 = 8192 + sq * 32; }
}

__device__ __forceinline__ void ssd_s1_item(const Params& p, int it, float* sm) {
  const int tid = (tidx_opaque() & 255), lane = tid & 63, wave = tid >> 6;
  const int r = lane & 31, hh = lane >> 5;
  float* xw = sm;
  float* Bs = sm + 4096;
  float* s_cum = Bs + 8192;
  float* s_w = s_cum + 64;
  int seq, tok0, L, h;
  ssd_decode(it, seq, tok0, L, h);
  const int g = h >> 3;
  const float a_neg = -expf(p.ssd_a_log[h]);
  float4 xr[4], br[8];
#pragma unroll
  for (int i = 0; i < 4; ++i) {
    int idx4 = tid + 256 * i;
    int s = idx4 >> 4, c4 = idx4 & 15;
    xr[i] = make_float4(0.f, 0.f, 0.f, 0.f);
    if (s < L) xr[i] = *(const float4*)(p.xs + (size_t)(tok0 + s) * 1024 + h * 64 + c4 * 4);
  }
#pragma unroll
  for (int i = 0; i < 8; ++i) {
    int idx4 = tid + 256 * i;
    int s = idx4 >> 5, c4 = idx4 & 31;
    br[i] = make_float4(0.f, 0.f, 0.f, 0.f);
    if (s < L) br[i] = *(const float4*)(p.bm + (size_t)(tok0 + s) * 256 + g * 128 + c4 * 4);
  }
  if (wave == 0) {
    float dtv = lane < L ? p.dt[(tok0 + lane) * 16 + h] : 0.f;
    float v = dtv * a_neg;
#pragma unroll
    for (int o = 1; o < 64; o <<= 1) { float n = __shfl_up(v, o); if (lane >= o) v += n; }
    if (lane < L) p.cumb[(tok0 + lane) * 16 + h] = v;
    s_cum[lane] = v;
    float last = __shfl(v, L - 1);
    s_w[lane] = lane < L ? expf(last - v) * dtv : 0.f;
  }
  __syncthreads();
#pragma unroll
  for (int i = 0; i < 4; ++i) {
    int idx4 = tid + 256 * i;
    int s = idx4 >> 4, c4 = idx4 & 15;
    float w = s_w[s];
    *(float4*)(xw + s * 64 + c4 * 4) = make_float4(xr[i].x * w, xr[i].y * w, xr[i].z * w, xr[i].w * w);
  }
#pragma unroll
  for (int i = 0; i < 8; ++i) {
    int idx4 = tid + 256 * i;
    int s = idx4 >> 5, c4 = idx4 & 31;
    *(float4*)(Bs + s * 128 + c4 * 4) = br[i];
  }
  __syncthreads();
  const int pi = wave & 1, nj0 = (wave >> 1) * 2;
  f32x16 acc0 = zero16(), acc1 = zero16();
  for (int kb = 0; kb < L / 2; kb += 8) {
    float a[8], b0[8], b1[8];
#pragma unroll
    for (int q = 0; q < 8; ++q) {
      int k = 2 * (kb + q) + hh;
      a[q] = xw[k * 64 + pi * 32 + r];
      b0[q] = Bs[k * 128 + nj0 * 32 + r];
      b1[q] = Bs[k * 128 + nj0 * 32 + 32 + r];
    }
    __builtin_amdgcn_s_setprio(1);
#pragma unroll
    for (int q = 0; q < 8; ++q) {
      acc0 = __builtin_amdgcn_mfma_f32_32x32x2f32(a[q], b0[q], acc0, 0, 0, 0);
      acc1 = __builtin_amdgcn_mfma_f32_32x32x2f32(a[q], b1[q], acc1, 0, 0, 0);
    }
    __builtin_amdgcn_s_setprio(0);
  }
  const float declast = expf(s_cum[L - 1]);
  if (seq < 2) {
#pragma unroll
    for (int j = 0; j < 2; ++j) {
      const f32x16& a = j == 0 ? acc0 : acc1;
#pragma unroll
      for (int q = 0; q < 16; ++q) {
        int pp = pi * 32 + (q & 3) + 8 * (q >> 2) + 4 * hh;
        int n = (nj0 + j) * 32 + r;
        p.xcur[(size_t)it * 8192 + pp * 128 + n] = a[q];
      }
    }
  } else {
    const size_t ob = (size_t)((seq - 2) * 16 + h) * 8192;
    float h0v[2][16];
#pragma unroll
    for (int j = 0; j < 2; ++j)
#pragma unroll
      for (int q = 0; q < 16; ++q) {
        int pp = pi * 32 + (q & 3) + 8 * (q >> 2) + 4 * hh;
        h0v[j][q] = p.state_ssm[ob + pp * 128 + (nj0 + j) * 32 + r];
      }
#pragma unroll
    for (int j = 0; j < 2; ++j) {
      const f32x16& a = j == 0 ? acc0 : acc1;
#pragma unroll
      for (int q = 0; q < 16; ++q) {
        int pp = pi * 32 + (q & 3) + 8 * (q >> 2) + 4 * hh;
        p.out[O_SSMS + ob + pp * 128 + (nj0 + j) * 32 + r] = declast * h0v[j][q] + a[q];
      }
    }
  }
  __syncthreads();
}

__device__ __forceinline__ void ssd_s2_item(const Params& p, int it) {
  const int seq = it >> 9, h = (it >> 5) & 15, e = (it & 31) * 256 + (tidx_opaque() & 255);
  float* __restrict__ S = p.xcur + (size_t)(seq * 64 * 16 + h) * 8192 + e;
  const float* __restrict__ cum = p.cumb + (seq * 4096 + 63) * 16 + h;
  float hst = 0.f;
  for (int c0 = 0; c0 < 64; c0 += 8) {
    float tmp[8], dec[8];
#pragma unroll
    for (int i = 0; i < 8; ++i) { tmp[i] = S[(size_t)(c0 + i) * 16 * 8192]; dec[i] = cum[(c0 + i) * 64 * 16]; }
#pragma unroll
    for (int i = 0; i < 8; ++i) {
      S[(size_t)(c0 + i) * 16 * 8192] = hst;
      hst = expf(dec[i]) * hst + tmp[i];
    }
  }
  p.out[O_SSMP + (size_t)(seq * 16 + h) * 8192 + e] = hst;
}

__device__ __forceinline__ void ssd_s3_item(const Params& p, int it, float* sm) {
  const int tid = (tidx_opaque() & 255), lane = tid & 63, wave = tid >> 6;
  const int r = lane & 31, hh = lane >> 5;
  float* bufA = sm;
  float* bufB = sm + 4160;
  float* Wb = sm + 8320;
  float* xb = sm + 12480;
  float* s_cum = sm + 16576;
  float* s_dt = s_cum + 64;
  int seq, tok0, L, h;
  ssd_decode(it, seq, tok0, L, h);
  const int g = h >> 3;
  const int ti = wave >> 1, si = wave & 1, pi = wave & 1;
  const float* hprev = seq < 2 ? p.xcur + (size_t)it * 8192 : p.state_ssm + (size_t)((seq - 2) * 16 + h) * 8192;
  float4 cr[2][4], br[2][4], hr[2][4], xr[4];
  float zr[16];
#pragma unroll
  for (int nh = 0; nh < 2; ++nh)
#pragma unroll
    for (int i = 0; i < 4; ++i) {
      int idx4 = tid + 256 * i;
      int s = idx4 >> 4, c4 = idx4 & 15;
      cr[nh][i] = make_float4(0.f, 0.f, 0.f, 0.f);
      br[nh][i] = cr[nh][i];
      if (s < L) {
        cr[nh][i] = *(const float4*)(p.cm + (size_t)(tok0 + s) * 256 + g * 128 + nh * 64 + c4 * 4);
        br[nh][i] = *(const float4*)(p.bm + (size_t)(tok0 + s) * 256 + g * 128 + nh * 64 + c4 * 4);
      }
      hr[nh][i] = *(const float4*)(hprev + s * 128 + nh * 64 + c4 * 4);
    }
#pragma unroll
  for (int i = 0; i < 4; ++i) {
    int idx4 = tid + 256 * i;
    int s = idx4 >> 4, c4 = idx4 & 15;
    xr[i] = make_float4(0.f, 0.f, 0.f, 0.f);
    if (s < L) xr[i] = *(const float4*)(p.xs + (size_t)(tok0 + s) * 1024 + h * 64 + c4 * 4);
  }
#pragma unroll
  for (int q = 0; q < 16; ++q) {
    int t = ti * 32 + (q & 3) + 8 * (q >> 2) + 4 * hh;
    zr[q] = t < L ? p.R1[(size_t)(tok0 + t) * ABN + 2640 + h * 64 + pi * 32 + r] : 0.f;
  }
  if (tid < 64) {
    s_cum[tid] = tid < L ? p.cumb[(tok0 + tid) * 16 + h] : 0.f;
    s_dt[tid] = tid < L ? p.dt[(tok0 + tid) * 16 + h] : 0.f;
  }
#define ST4(dst, v) do { float* _d = (dst); _d[0] = (v).x; _d[1] = (v).y; _d[2] = (v).z; _d[3] = (v).w; } while (0)
#define MM32(acc, pa, pb)                                                        \
  for (int kb = 0; kb < 32; kb += 8) {                                           \
    float _a[8], _b[8];                                                          \
    _Pragma("unroll") for (int q = 0; q < 8; ++q) { _a[q] = (pa)[2 * (kb + q)]; _b[q] = (pb)[2 * (kb + q)]; } \
    __builtin_amdgcn_s_setprio(1);                                             \
    _Pragma("unroll") for (int q = 0; q < 8; ++q) acc = __builtin_amdgcn_mfma_f32_32x32x2f32(_a[q], _b[q], acc, 0, 0, 0); \
    __builtin_amdgcn_s_setprio(0);                                             \
  }
  f32x16 cb = zero16();
#pragma unroll
  for (int nh = 0; nh < 2; ++nh) {
#pragma unroll
    for (int i = 0; i < 4; ++i) {
      int idx4 = tid + 256 * i;
      int s = idx4 >> 4, c4 = idx4 & 15;
      ST4(bufA + s * 65 + c4 * 4, cr[nh][i]);
      ST4(bufB + s * 65 + c4 * 4, br[nh][i]);
    }
    __syncthreads();
    {
      const float* pa = bufA + (ti * 32 + r) * 65 + hh;
      const float* pb = bufB + (si * 32 + r) * 65 + hh;
      MM32(cb, pa, pb)
    }
    __syncthreads();
  }
  {
    const int s = si * 32 + r;
    const float cs = s_cum[s], ds = s_dt[s];
#pragma unroll
    for (int q = 0; q < 16; ++q) {
      int t = ti * 32 + (q & 3) + 8 * (q >> 2) + 4 * hh;
      float val = (s <= t) ? cb[q] * expf(s_cum[t] - cs) * ds : 0.f;
      Wb[t * 65 + s] = val;
    }
  }
#pragma unroll
  for (int i = 0; i < 4; ++i) {
    int idx4 = tid + 256 * i;
    int s = idx4 >> 4, c4 = idx4 & 15;
    *(float4*)(xb + s * 64 + c4 * 4) = xr[i];
  }
#pragma unroll
  for (int i = 0; i < 4; ++i) {
    int idx4 = tid + 256 * i;
    int s = idx4 >> 4, c4 = idx4 & 15;
    ST4(bufA + s * 65 + c4 * 4, cr[0][i]);
    ST4(bufB + s * 65 + c4 * 4, hr[0][i]);
  }
  __syncthreads();
  f32x16 y1 = zero16(), y2 = zero16();
  for (int kb = 0; kb < 32; kb += 8) {
    float a[8], b[8];
#pragma unroll
    for (int q = 0; q < 8; ++q) { a[q] = Wb[(ti * 32 + r) * 65 + 2 * (kb + q) + hh]; b[q] = xb[(2 * (kb + q) + hh) * 64 + pi * 32 + r]; }
    __builtin_amdgcn_s_setprio(1);
#pragma unroll
    for (int q = 0; q < 8; ++q) y1 = __builtin_amdgcn_mfma_f32_32x32x2f32(a[q], b[q], y1, 0, 0, 0);
    __builtin_amdgcn_s_setprio(0);
  }
  {
    const float* pa = bufA + (ti * 32 + r) * 65 + hh;
    const float* pb = bufB + (pi * 32 + r) * 65 + hh;
    MM32(y2, pa, pb)
  }
  __syncthreads();
#pragma unroll
  for (int i = 0; i < 4; ++i) {
    int idx4 = tid + 256 * i;
    int s = idx4 >> 4, c4 = idx4 & 15;
    ST4(bufA + s * 65 + c4 * 4, cr[1][i]);
    ST4(bufB + s * 65 + c4 * 4, hr[1][i]);
  }
  __syncthreads();
  {
    const float* pa = bufA + (ti * 32 + r) * 65 + hh;
    const float* pb = bufB + (pi * 32 + r) * 65 + hh;
    MM32(y2, pa, pb)
  }
  {
    const int pc = pi * 32 + r;
    const float Dh = p.ssd_d[h];
#pragma unroll
    for (int q = 0; q < 16; ++q) {
      int t = ti * 32 + (q & 3) + 8 * (q >> 2) + 4 * hh;
      if (t < L) {
        int tok = tok0 + t;
        float y = y1[q] + expf(s_cum[t]) * y2[q] + Dh * xb[t * 64 + pc];
        float z = zr[q];
        p.R2[(size_t)tok * 1024 + h * 64 + pc] = y * siluf_(z);
      }
    }
  }
#undef ST4
#undef MM32
  __syncthreads();
}

__device__ __forceinline__ void phase_ssdnorm(const Params& p) {
  const int lane = (tidx_opaque() & 255) & 63, wave = (tidx_opaque() & 255) >> 6;
  FOR_ITEMS(NTOK * 2 / 4, it) {
    int pair = it * 4 + wave;
    int tok = pair >> 1, g = pair & 1;
    const float* y = p.R2 + (size_t)tok * 1024 + g * 512 + lane * 8;
    float4 v0 = *(const float4*)y, v1 = *(const float4*)(y + 4);
    float ss = v0.x * v0.x + v0.y * v0.y + v0.z * v0.z + v0.w * v0.w + v1.x * v1.x + v1.y * v1.y + v1.z * v1.z + v1.w * v1.w;
    ss = wave_sum(ss);
    float rn = rsqrtf(ss * (1.f / 512.f) + 1e-6f);
    const float* w = p.ssd_norm_w + g * 512 + lane * 8;
    float4 w0 = *(const float4*)w, w1 = *(const float4*)(w + 4);
    uint4 o;
    o.x = pack2(v0.x * rn * w0.x, v0.y * rn * w0.y);
    o.y = pack2(v0.z * rn * w0.z, v0.w * rn * w0.w);
    o.z = pack2(v1.x * rn * w1.x, v1.y * rn * w1.y);
    o.w = pack2(v1.z * rn * w1.z, v1.w * rn * w1.w);
    *(uint4*)(p.Abuf + (size_t)tok * 2048 + 1024 + g * 512 + lane * 8) = o;
  }
}

__device__ __forceinline__ unsigned ord_u(float f) {
  unsigned u = __float_as_uint(f);
  return (u & 0x80000000u) ? ~u : (u | 0x80000000u);
}
template <int NREG>
__device__ __forceinline__ void topk_wave(const float* sc, int nkeys, int* selout, int lane) {
  unsigned v[NREG];
#pragma unroll
  for (int r = 0; r < NREG; ++r) {
    int key = r * 64 + lane;
    v[r] = key < nkeys ? ord_u(sc[key]) : 0u;
  }
  unsigned prefix = 0;
#pragma unroll 1
  for (int bit = 31; bit >= 0; --bit) {
    unsigned cand = prefix | (1u << bit);
    int cnt = 0;
#pragma unroll
    for (int r = 0; r < NREG; ++r) cnt += __popcll(__ballot(v[r] >= cand));
    if (cnt >= 256) prefix = cand;
  }
  int cgt = 0;
#pragma unroll
  for (int r = 0; r < NREG; ++r) cgt += __popcll(__ballot(v[r] > prefix));
  const int need = 256 - cgt;
  int base = 0, tie_taken = 0;
#pragma unroll
  for (int r = 0; r < NREG; ++r) {
    bool gt = v[r] > prefix, eq = v[r] == prefix;
    unsigned long long em = __ballot(eq);
    int erank = __builtin_amdgcn_mbcnt_hi((unsigned)(em >> 32), __builtin_amdgcn_mbcnt_lo((unsigned)em, 0));
    bool take = gt || (eq && (tie_taken + erank < need));
    tie_taken += __popcll(em);
    unsigned long long m = __ballot(take);
    int pos = base + __builtin_amdgcn_mbcnt_hi((unsigned)(m >> 32), __builtin_amdgcn_mbcnt_lo((unsigned)m, 0));
    if (take && pos < 256) selout[pos] = r * 64 + lane;
    base += __popcll(m);
  }
}

__device__ __forceinline__ void topk_item(const Params& p, int item) {
  const int lane = (tidx_opaque() & 255) & 63, wave = (tidx_opaque() & 255) >> 6;
  const int tok = item * 4 + wave;
  int seq, t, pos, T;
  tok_info(tok, seq, t, pos, T);
  const int nkeys = seq < 2 ? ((t >> 6) + 1) * 64 : 1056;
  int* so = p.sel + (size_t)tok * 256;
  const float* sc = p.R2 + (size_t)tok * 4096;
  if (nkeys <= 256) {
#pragma unroll
    for (int i = 0; i < 4; ++i) so[i * 64 + lane] = i * 64 + lane;
    return;
  }
  if (nkeys <= 1024) topk_wave<16>(sc, nkeys, so, lane);
  else if (nkeys <= 1088) topk_wave<17>(sc, nkeys, so, lane);
  else if (nkeys <= 2048) topk_wave<32>(sc, nkeys, so, lane);
  else topk_wave<64>(sc, nkeys, so, lane);
}

__device__ __forceinline__ void attn_item(const Params& p, int tok0, int g, char* smem) {
  const int tid = (tidx_opaque() & 255), lane = tid & 63, wave = tid >> 6;
  float* qs = (float*)smem + wave * 1792;
  float* ps = qs + 512;
  int* rows = (int*)(ps + 1024);
  const int tok = tok0 + wave;
  int seq, t, pos, T;
  tok_info(tok, seq, t, pos, T);
  const int nkeys = seq < 2 ? ((t >> 6) + 1) * 64 : 1056;
  const int nsel = min(nkeys, 256);
  const int nkb = nsel >> 4;
  const int kvb = kv_base(seq);
  const int c16 = lane & 15, q4 = lane >> 4;
  bf16x8 qa[4];
#pragma unroll
  for (int ks = 0; ks < 4; ++ks) {
#pragma unroll
    for (int e = 0; e < 8; ++e) qa[ks][e] = 0;
    if (c16 < 4) qa[ks] = *(const bf16x8*)(p.qb + ((size_t)tok * 8 + g * 4 + c16) * 128 + ks * 32 + q4 * 8);
  }
#pragma unroll
  for (int i = 0; i < 4; ++i) {
    int j = i * 64 + lane;
    int idx = (j < nsel) ? p.sel[(size_t)tok * 256 + j] : 0;
    rows[j] = kvb + idx;
  }
  __builtin_amdgcn_wave_barrier();
  f32x4 sacc[16];
#pragma unroll
  for (int kb = 0; kb < 16; ++kb) {
    sacc[kb][0] = -INFINITY; sacc[kb][1] = -INFINITY; sacc[kb][2] = -INFINITY; sacc[kb][3] = -INFINITY;
    if (kb < nkb) {
      const int row = rows[kb * 16 + c16];
      const u16* kp = p.Kb + (size_t)row * 256 + g * 128 + q4 * 8;
      bf16x8 b0 = *(const bf16x8*)(kp), b1 = *(const bf16x8*)(kp + 32), b2 = *(const bf16x8*)(kp + 64), b3 = *(const bf16x8*)(kp + 96);
      f32x4 acc = {0.f, 0.f, 0.f, 0.f};
      acc = __builtin_amdgcn_mfma_f32_16x16x32_bf16(qa[0], b0, acc, 0, 0, 0);
      acc = __builtin_amdgcn_mfma_f32_16x16x32_bf16(qa[1], b1, acc, 0, 0, 0);
      acc = __builtin_amdgcn_mfma_f32_16x16x32_bf16(qa[2], b2, acc, 0, 0, 0);
      acc = __builtin_amdgcn_mfma_f32_16x16x32_bf16(qa[3], b3, acc, 0, 0, 0);
      sacc[kb] = acc;
    }
  }
  const float scl = 0.08838834764831845f;
#pragma unroll
  for (int i = 0; i < 4; ++i) {
    float m = sacc[0][i];
#pragma unroll
    for (int kb = 1; kb < 16; ++kb) m = fmaxf(m, sacc[kb][i]);
#pragma unroll
    for (int o = 8; o > 0; o >>= 1) m = fmaxf(m, __shfl_xor(m, o));
    float sum = 0.f;
#pragma unroll
    for (int kb = 0; kb < 16; ++kb) { float e = __expf((sacc[kb][i] - m) * scl); sacc[kb][i] = e; sum += e; }
#pragma unroll
    for (int o = 8; o > 0; o >>= 1) sum += __shfl_xor(sum, o);
    const float inv = 1.f / sum;
#pragma unroll
    for (int kb = 0; kb < 16; ++kb) sacc[kb][i] *= inv;
  }
  if (q4 == 0) {
#pragma unroll
    for (int kb = 0; kb < 16; ++kb) *(f32x4*)(ps + (kb * 16 + c16) * 4) = sacc[kb];
  }
  __builtin_amdgcn_wave_barrier();
  float o[4][2];
#pragma unroll
  for (int r = 0; r < 4; ++r) o[r][0] = o[r][1] = 0.f;
  const u16* vbase = p.Vb + g * 128 + lane * 2;
  for (int j0 = 0; j0 < nsel; j0 += 64) {
    unsigned vv[64];
#pragma unroll
    for (int u = 0; u < 64; u += 4) {
      int4 r4 = *(const int4*)(rows + j0 + u);
      vv[u + 0] = *(const unsigned*)(vbase + (size_t)r4.x * 256);
      vv[u + 1] = *(const unsigned*)(vbase + (size_t)r4.y * 256);
      vv[u + 2] = *(const unsigned*)(vbase + (size_t)r4.z * 256);
      vv[u + 3] = *(const unsigned*)(vbase + (size_t)r4.w * 256);
    }
#pragma unroll
    for (int u = 0; u < 64; ++u) {
      float4 p4 = *(const float4*)(ps + (j0 + u) * 4);
      float v0 = bflo(vv[u]), v1 = bfhi(vv[u]);
      o[0][0] += p4.x * v0; o[0][1] += p4.x * v1;
      o[1][0] += p4.y * v0; o[1][1] += p4.y * v1;
      o[2][0] += p4.z * v0; o[2][1] += p4.z * v1;
      o[3][0] += p4.w * v0; o[3][1] += p4.w * v1;
    }
  }
#pragma unroll
  for (int r = 0; r < 4; ++r)
    *(unsigned*)(p.Abuf + (size_t)tok * 2048 + (g * 4 + r) * 128 + lane * 2) = pack2(o[r][0], o[r][1]);
  __builtin_amdgcn_wave_barrier();
}

__device__ __forceinline__ void lru_conv_item(const Params& p, int tok) {
  const int tid = (tidx_opaque() & 255);
  int seq, t, pos, T;
  tok_info(tok, seq, t, pos, T);
  const float* gx = p.R1 + (size_t)tok * 4096 + 2048;
  float* xcf = p.R2 + (size_t)NTOK * 2048 + (size_t)tok * 2048;
  float4 u[2][4], w[2][5];
#pragma unroll
  for (int i = 0; i < 2; ++i) {
    int c = (tid + 256 * i) * 4;
#pragma unroll
    for (int d = 0; d < 4; ++d) {
      int tt = t - d;
      if (tt >= 0) u[i][d] = *(const float4*)(gx + c - d * 4096);
      else if (seq < 2) u[i][d] = make_float4(0.f, 0.f, 0.f, 0.f);
      else u[i][d] = *(const float4*)(p.state_lru_conv + ((seq - 2) * 3 + (3 + tt)) * 2048 + c);
    }
    w[i][0] = *(const float4*)(p.lru_conv_w + c); w[i][1] = *(const float4*)(p.lru_conv_w + 2048 + c);
    w[i][2] = *(const float4*)(p.lru_conv_w + 2 * 2048 + c); w[i][3] = *(const float4*)(p.lru_conv_w + 3 * 2048 + c);
    w[i][4] = *(const float4*)(p.lru_conv_b + c);
  }
#pragma unroll
  for (int i = 0; i < 2; ++i) {
    int c = (tid + 256 * i) * 4;
    float4 o;
    o.x = w[i][4].x + w[i][3].x * u[i][0].x + w[i][2].x * u[i][1].x + w[i][1].x * u[i][2].x + w[i][0].x * u[i][3].x;
    o.y = w[i][4].y + w[i][3].y * u[i][0].y + w[i][2].y * u[i][1].y + w[i][1].y * u[i][2].y + w[i][0].y * u[i][3].y;
    o.z = w[i][4].z + w[i][3].z * u[i][0].z + w[i][2].z * u[i][1].z + w[i][1].z * u[i][2].z + w[i][0].z * u[i][3].z;
    o.w = w[i][4].w + w[i][3].w * u[i][0].w + w[i][2].w * u[i][1].w + w[i][1].w * u[i][2].w + w[i][0].w * u[i][3].w;
    *(float4*)(xcf + c) = o;
    uint2 ob; ob.x = pack2(o.x, o.y); ob.y = pack2(o.z, o.w);
    *(uint2*)(p.Abuf + (size_t)tok * 2048 + c) = ob;
    if (t >= T - 3) {
      int j = t - (T - 3);
      float* dst = seq < 2 ? p.out + O_LRUCP + (seq * 3 + j) * 2048 : p.out + O_LRUCS + ((seq - 2) * 3 + j) * 2048;
      *(float4*)(dst + c) = u[i][0];
    }
  }
}

__device__ __forceinline__ void lru_agg_item(const Params& p, int it) {
  const int chunk = it >> 3, ch = (it & 7) * 256 + (tidx_opaque() & 255);
  const float* ab = p.R2 + (size_t)chunk * 128 * 2048 + ch;
  const float* ub = ab + (size_t)NTOK * 2048;
  float A = 1.f, h = 0.f;
#pragma unroll 8
  for (int t = 0; t < 128; ++t) {
    float a = ab[(size_t)t * 2048], u = ub[(size_t)t * 2048];
    h = a * h + u;
    A *= a;
  }
  p.aggA[chunk * 2048 + ch] = A;
  p.aggU[chunk * 2048 + ch] = h;
}

__device__ __forceinline__ float gelu_tanh(float x) {
  float y = 0.7978845608028654f * (x + 0.044715f * x * x * x);
  float e = __expf(2.f * y);
  float th = 1.f - 2.f / (e + 1.f);
  return 0.5f * x * (1.f + th);
}

__device__ __forceinline__ void lru_scan_item(const Params& p, int it) {
  int tok0, L, seq;
  const int ch = (it & 7) * 256 + (tidx_opaque() & 255);
  float h;
  bool last;
  if (it < 512) {
    int chunk = it >> 3;
    seq = chunk >> 5;
    int cs = chunk & 31;
    tok0 = chunk * 128; L = 128;
    h = 0.f;
    {
      const float* __restrict__ gA = p.aggA + seq * 32 * 2048 + ch;
      const float* __restrict__ gU = p.aggU + seq * 32 * 2048 + ch;
#pragma unroll 8
      for (int c = 0; c < cs; ++c) h = gA[c * 2048] * h + gU[c * 2048];
    }
    last = cs == 31;
  } else {
    int sq = (it - 512) >> 3;
    seq = 2 + sq;
    tok0 = 8192 + sq * 32; L = 32;
    h = p.state_lru[sq * 2048 + ch];
    last = true;
  }
  const float* ab = p.R2 + (size_t)tok0 * 2048 + ch;
  const float* ub = ab + (size_t)NTOK * 2048;
  const float* gt = p.R1 + (size_t)tok0 * 4096 + ch;
  u16* yo = p.Abuf + (size_t)tok0 * 2048 + ch;
#pragma unroll 8
  for (int t = 0; t < L; ++t) {
    float a = ab[(size_t)t * 2048], u = ub[(size_t)t * 2048], gv = gt[(size_t)t * 4096];
    h = a * h + u;
    yo[(size_t)t * 2048] = f2bf(h * gelu_tanh(gv));
  }
  if (last) {
    if (seq < 2) p.out[O_LRUP + seq * 2048 + ch] = h;
    else p.out[O_LRUS + (seq - 2) * 2048 + ch] = h;
  }
}

#define XB_TMO      128
#define XB_XCNT(j)  (256  + 64 * (j))
#define XB_XSUB(j)  (1280 + 64 * (j))
#define XB_XGEN(j)  (2304 + 64 * (j))
#define XB_TOP      3328
#define XB_TOPGEN   3392
#define XCD_BAR_WORDS 3456
#define XB_SPIN_CAP (1u << 18)
#define LAS __attribute__((address_space(3)))
__device__ __forceinline__ unsigned xb_ld(unsigned* p)              { return __hip_atomic_load(p, __ATOMIC_RELAXED, __HIP_MEMORY_SCOPE_AGENT); }
__device__ __forceinline__ unsigned xb_add(unsigned* p, unsigned v) { return __hip_atomic_fetch_add(p, v, __ATOMIC_RELAXED, __HIP_MEMORY_SCOPE_AGENT); }
__device__ __forceinline__ unsigned xb_xcc_id() { return (unsigned)__builtin_amdgcn_s_getreg((3 << 11) | 20) & 0xFu; }
#define XB_SPIN(cond, bar) do { unsigned _sp = 0; while (cond) { __builtin_amdgcn_s_sleep(1); \
    if ((++_sp & 255u) == 0u) { if (xb_ld(&(bar)[XB_TMO])) break; if (_sp > XB_SPIN_CAP) { atomicAdd(&(bar)[XB_TMO], 1u); break; } } } } while (0)
struct XcdBarrier { unsigned* bar; unsigned x; volatile LAS unsigned* st; };
__device__ __forceinline__ XcdBarrier xcd_barrier_post(unsigned* bar, volatile LAS unsigned* st) {
    XcdBarrier b; b.bar = bar; b.x = xb_xcc_id(); b.st = st;
    if (threadIdx.x == 0) (void)xb_add(&bar[XB_XCNT(b.x)], 1u);
    return b;
}
__device__ __forceinline__ void xcd_barrier_complete(unsigned* bar, unsigned x, unsigned& nloc, unsigned& nx) {
    const unsigned G = gridDim.x * gridDim.y * gridDim.z;
    unsigned sum, cnt, mine, sp = 0u;
    for (;;) {
        sum = 0u; cnt = 0u; mine = 0u;
#pragma unroll
        for (unsigned j = 0; j < 16; ++j) { const unsigned c = xb_ld(&bar[XB_XCNT(j)]); sum += c; cnt += (c > 0u) ? 1u : 0u; mine = (j == x) ? c : mine; }
        if (sum == G) break;
        __builtin_amdgcn_s_sleep(1);
        if ((++sp & 255u) == 0u) { if (xb_ld(&bar[XB_TMO])) break; if (sp > XB_SPIN_CAP) { atomicAdd(&bar[XB_TMO], 1u); break; } }
    }
    nloc = mine > 0u ? mine : 1u; nx = cnt > 0u ? cnt : 1u;
}
__device__ __forceinline__ void xcd_barrier(unsigned* bar, unsigned x, volatile LAS unsigned* st) {
    asm volatile("s_waitcnt vmcnt(0)" ::: "memory");
    __syncthreads();
    if (threadIdx.x == 0) {
        __builtin_amdgcn_s_waitcnt(0);
        unsigned nloc = st[0], nx = st[1];
        if (nloc == 0u) { xcd_barrier_complete(bar, x, nloc, nx); st[0] = nloc; st[1] = nx; }
        const unsigned old = xb_add(&bar[XB_XSUB(x)], 1u);
        const unsigned gen = old / nloc;
        if (old + 1u == (gen + 1u) * nloc) {
            __builtin_amdgcn_fence(__ATOMIC_RELEASE, "agent");
            asm volatile("s_waitcnt vmcnt(0)" ::: "memory");
            const unsigned og = xb_add(&bar[XB_TOP], 1u);
            const unsigned tg = og / nx;
            if (og + 1u == (tg + 1u) * nx) xb_add(&bar[XB_TOPGEN], 1u);
            else XB_SPIN(xb_ld(&bar[XB_TOPGEN]) == tg, bar);
            __builtin_amdgcn_fence(__ATOMIC_ACQUIRE, "agent");
            xb_add(&bar[XB_XGEN(x)], 1u);
            asm volatile("s_waitcnt vmcnt(0)" ::: "memory");
        } else {
            XB_SPIN(xb_ld(&bar[XB_XGEN(x)]) == gen, bar);
            __builtin_amdgcn_fence(__ATOMIC_ACQUIRE, "agent");
            asm volatile("s_waitcnt vmcnt(0)" ::: "memory");
        }
    }
    __syncthreads();
}

__device__ __forceinline__ void run_phase(const Params& p0, const int ph, char* smem, const bool dup = false) {
  const Params& p = opaque_params(p0);
  const float* mod0 = p.mod;
  const float* mod1 = p.mod + 18 * 12288;
  char* hsm = smem + (tidx_opaque() >> 8) * HALF_LDS;
  switch (ph) {
    case 0:
      FOR_ITEMS(1536 + 5984 + 4608, it) {
        if (it < 1536) ada_item(p, it, (float*)hsm);
        else if (it < 1536 + 5984) conv_item(p, it - 1536, (float*)hsm);
        else cache_item(p, it - 1536 - 5984);
      }
      break;
    case 1: phase_normmod<true>(p, nullptr, p.norm_mix_w, p.modp, 0, 2048); break;
    case 2: {
      GemmArgs g{}; g.A = p.Abuf; g.lda = 2048; g.B = p.Wt_in_ab; g.K = 2048; g.ntn = 21; g.ntiles = 34 * 21;
      g.C = p.R1; g.ldc = ABN; g.nvalid = ABN;
      gemm_phase<EPI_F32, 0>(p, g, smem);
    } break;
    case 3:
      FOR_ITEMS(NTOK / 2, it) post_proj_item(p, it);
      break;
    case 4:
      FOR_ITEMS(2176 + 2304, it) {
        if (it < 2304) ssd_s1_item(p, it, (float*)hsm);
        else idx_item(p, it - 2304);
      }
      break;
    case 5:
      FOR_ITEMS(1024 + 2176, it) {
        if (it < 1024) { if (!dup) ssd_s2_item(p, it); }
        else topk_item(p, it - 1024);
      }
      break;
    case 6:
      FOR_ITEMS(2304, it) { ssd_s3_item(p, it, (float*)hsm); }
      if (gridDim.x == 256) {
        const int hb = tidx_opaque() >> 8;
        const int b = blockIdx.x, x = b & 7, w = (b >> 3) * 2 + hb;
        const int tbase = (x >> 2) * 4096 + (x & 1) * 2048, gg = (x >> 1) & 1;
        for (int k = 0; k < 8; ++k) attn_item(p, tbase + (w + 64 * k) * 4, gg, hsm);
        if (b < 128) { int it = b * 2 + hb; attn_item(p, 8192 + (it >> 1) * 4, it & 1, hsm); }
      } else {
        FOR_ITEMS(4352, it) attn_item(p, (it >> 1) * 4, it & 1, hsm);
      }
      break;
    case 7: phase_ssdnorm(p); break;
    case 8: {
      GemmArgs g{}; g.A = p.Abuf; g.lda = 2048; g.B = p.Wt_out_ab; g.K = 2048; g.ntn = 8; g.ntiles = 32 * 8;
      g.xin = nullptr; g.xout = p.xcur; g.gate = mod0 + 4096;
      gemm_phase<EPI_RESID, 2>(p, g, smem);
    } break;
    case 9: phase_normmod<false>(p, p.xcur, p.norm_ffn_w, mod0, 6144, 8192); break;
    case 10: {
      GemmArgs g{}; g.A = p.Abuf; g.lda = 2048; g.B = p.Wt_gu; g.K = 2048; g.ntn = 44; g.ntiles = 34 * 44;
      g.H = (u16*)p.R1;
      gemm_phase<EPI_SWIGLU, 0>(p, g, smem);
    } break;
    case 11: {
      GemmArgs g{}; g.A = (const u16*)p.R1; g.lda = FFN; g.B = p.Wt_down; g.K = FFN; g.ntn = 8; g.ntiles = 32 * 8;
      g.xin = p.xcur; g.xout = p.xcur; g.gate = mod0 + 10240;
      gemm_phase<EPI_RESID, 2>(p, g, smem);
    } break;
    case 12: phase_normmod<false>(p, p.xcur, p.norm_mix_w + 2048, mod1, 0, 2048); break;
    case 13: {
      GemmArgs g{}; g.A = p.Abuf; g.lda = 2048; g.B = p.Wt_in_c; g.K = 2048; g.ntn = 16; g.ntiles = 32 * 16;
      g.C = p.R1; g.ldc = 4096; g.nvalid = 4096;
      gemm_phase<EPI_F32, 2>(p, g, smem);
    } break;
    case 14:
      FOR_ITEMS(NTOK, it) lru_conv_item(p, it);
      break;
    case 15: {
      GemmArgs g{}; g.A = p.Abuf; g.lda = 2048; g.B = p.Wt_ax; g.K = 128; g.ntn = 32; g.ntiles = 34 * 32;
      gemm_phase<EPI_LRU, 1>(p, g, smem);
    } break;
    case 16:
      break;
    case 17:
      FOR_ITEMS(640, it) lru_scan_item(p, it);
      break;
    case 18: {
      GemmArgs g{}; g.A = p.Abuf; g.lda = 2048; g.B = p.Wt_out_c; g.K = 2048; g.ntn = 8; g.ntiles = 32 * 8;
      g.xin = p.xcur; g.xout = p.xcur; g.gate = mod1 + 4096;
      gemm_phase<EPI_RESID, 2>(p, g, smem);
    } break;
    case 19: phase_normmod<false>(p, p.xcur, p.norm_ffn_w + 2048, mod1, 6144, 8192); break;
    case 20: {
      GemmArgs g{}; g.A = p.Abuf; g.lda = 2048; g.B = p.Wt_gu + (size_t)11264 * 2048; g.K = 2048; g.ntn = 44; g.ntiles = 34 * 44;
      g.H = (u16*)p.R1;
      gemm_phase<EPI_SWIGLU, 0>(p, g, smem);
    } break;
    case 21: {
      GemmArgs g{}; g.A = (const u16*)p.R1; g.lda = FFN; g.B = p.Wt_down + (size_t)2048 * FFN; g.K = FFN; g.ntn = 8; g.ntiles = 32 * 8;
      g.xin = p.xcur; g.xout = p.out; g.gate = mod1 + 10240;
      gemm_phase<EPI_RESID, 2>(p, g, smem);
    } break;
    default: break;
  }
}

__device__ __forceinline__ void cnt_barrier(unsigned* ctr, unsigned target) {
  asm volatile("s_waitcnt vmcnt(0)" ::: "memory");
  __syncthreads();
  if (threadIdx.x == 0) {
    __builtin_amdgcn_fence(__ATOMIC_RELEASE, "agent");
    asm volatile("s_waitcnt vmcnt(0)" ::: "memory");
    __hip_atomic_fetch_add(ctr, 1u, __ATOMIC_RELAXED, __HIP_MEMORY_SCOPE_AGENT);
    unsigned sp = 0;
    while (__hip_atomic_load(ctr, __ATOMIC_RELAXED, __HIP_MEMORY_SCOPE_AGENT) < target) {
      __builtin_amdgcn_s_sleep(2);
      if (++sp > (1u << 22)) break;
    }
    __builtin_amdgcn_fence(__ATOMIC_ACQUIRE, "agent");
    asm volatile("s_waitcnt vmcnt(0)" ::: "memory");
  }
  __syncthreads();
}

#define PH(n) run_phase(p, n, smem); if ((DUP_MASK >> n) & 1) { XSYNC(); run_phase(p, n, smem, true); }
#define XSYNC() grid.sync()
#define PHS(n) PH(n) cnt_barrier(p.bar, (unsigned)(n) * gridDim.x)
#define PHT(n, t) PH(n) cnt_barrier(p.bar, (unsigned)(t) * gridDim.x)
__global__ void __launch_bounds__(512, 2) k_all(Params p) {
  __shared__ __attribute__((aligned(1024))) char smem[2 * HALF_LDS];
  cg::grid_group grid = cg::this_grid();
  if (blockIdx.x == 0 && threadIdx.x == 0) __hip_atomic_store(p.bar, 0u, __ATOMIC_RELAXED, __HIP_MEMORY_SCOPE_AGENT);
  PH(0);
  grid.sync();
  PHS(1); PHS(2); PHS(3); PHS(4); PHS(5); PHS(6); PHS(7); PHS(8); PHS(9); PHS(10);
  PHS(11); PHS(12); PHS(13); PHS(14); PHS(15);
  PHT(17, 16); PHT(18, 17); PHT(19, 18); PHT(20, 19); PH(21);
}

extern "C" void kernel_launch(void* const* d_in, const int* in_sizes, int n_in, void* d_out, int out_size,
                              void* d_ws, size_t ws_size, hipStream_t stream) {
  static int grid_blocks = 0;
  if (!grid_blocks) {
    int dev = 0, cus = 0, per_cu = 0;
    (void)hipGetDevice(&dev);
    (void)hipDeviceGetAttribute(&cus, hipDeviceAttributeMultiprocessorCount, dev);
    (void)hipOccupancyMaxActiveBlocksPerMultiprocessor(&per_cu, k_all, 512, 0);
    if (per_cu > 1) per_cu = 1;
    if (per_cu < 1) per_cu = 1;
    grid_blocks = cus * per_cu;
  }
  Params p{};
  const float** fin = (const float**)d_in;
  p.x_prompt = fin[0]; p.x_sample = fin[1]; p.cache_k = fin[2]; p.cache_v = fin[3]; p.cache_ki = fin[4];
  p.state_ssm = fin[5]; p.state_ssm_conv = fin[6]; p.state_lru = fin[7]; p.state_lru_conv = fin[8];
  p.c_prompt = fin[9]; p.c_sample = fin[10]; p.ada_w = fin[11]; p.ada_b = fin[12]; p.norm_mix_w = fin[13];
  p.norm_ffn_w = fin[14]; p.w_in_ab = fin[15]; p.q_norm_w = fin[16]; p.k_norm_w = fin[17]; p.ssd_conv_w = fin[18];
  p.ssd_conv_b = fin[19]; p.ssd_dt_bias = fin[20]; p.ssd_a_log = fin[21]; p.ssd_d = fin[22]; p.ssd_norm_w = fin[23];
  p.w_out_ab = fin[24]; p.w_in_c = fin[25]; p.lru_conv_w = fin[26]; p.lru_conv_b = fin[27]; p.lru_w_a = fin[28];
  p.lru_b_a = fin[29]; p.lru_w_x = fin[30]; p.lru_b_x = fin[31]; p.lru_lambda = fin[32]; p.w_out_c = fin[33];
  p.ffn_w_gate = fin[34]; p.ffn_w_up = fin[35]; p.ffn_w_down = fin[36];
  p.out = (float*)d_out;
  char* ws = (char*)d_ws;
  size_t off = 0;
  auto take = [&](size_t bytes) { size_t o = off; off += (bytes + 255) & ~(size_t)255; return ws + o; };
  p.Wt_in_ab = (u16*)take((size_t)5376 * 2048 * 2);
  p.Wt_out_ab = (u16*)take((size_t)2048 * 2048 * 2);
  p.Wt_gu = (u16*)take((size_t)2 * 11264 * 2048 * 2);
  p.Wt_down = (u16*)take((size_t)2 * 2048 * 5632 * 2);
  p.Wt_in_c = (u16*)take((size_t)4096 * 2048 * 2);
  p.Wt_ax = (u16*)take((size_t)16 * 256 * 128 * 2);
  p.Wt_out_c = (u16*)take((size_t)2048 * 2048 * 2);
  p.mod = (float*)take((size_t)2 * 18 * 12288 * 4);
  p.modp = (float*)take((size_t)4 * 2 * 18 * 12288 * 4);
  p.Abuf = (u16*)take((size_t)NTOK * 2048 * 2);
  p.R1 = (float*)take((size_t)NTOK * ABN * 4);
  p.R2 = (float*)take((size_t)NTOK * 4096 * 4);
  p.xcur = (float*)take((size_t)NTOK * 2048 * 4);
  p.qb = (u16*)take((size_t)NTOK * 1024 * 2);
  p.qib = (u16*)take((size_t)NTOK * 1024 * 2);
  p.wi = (float*)take((size_t)NTOK * 16 * 4);
  p.Kb = (u16*)take((size_t)25088 * 256 * 2);
  p.Vb = (u16*)take((size_t)25088 * 256 * 2);
  p.kib = (u16*)take((size_t)25088 * 64 * 2);
  p.xs = (float*)take((size_t)NTOK * 1024 * 4);
  p.bm = (float*)take((size_t)NTOK * 256 * 4);
  p.cm = (float*)take((size_t)NTOK * 256 * 4);
  p.dt = (float*)take((size_t)NTOK * 16 * 4);
  p.cumb = (float*)take((size_t)NTOK * 16 * 4);
  p.sel = (int*)take((size_t)NTOK * 256 * 4);
  p.aggA = (float*)take((size_t)64 * 2048 * 4);
  p.aggU = (float*)take((size_t)64 * 2048 * 4);
  p.bar = (unsigned*)take((size_t)XCD_BAR_WORDS * 4);
  if (off > ws_size) fprintf(stderr, "workspace too small: need %zu have %zu\n", off, ws_size);
  void* args[] = {&p};
  hipError_t e = hipLaunchCooperativeKernel((void*)k_all, dim3(grid_blocks), dim3(512), args, 0, stream);
  if (e != hipSuccess) fprintf(stderr, "cooperative launch failed: %s (grid %d)\n", hipGetErrorString(e), grid_blocks);
}
```

```cpp
#include <hip/hip_runtime.h>
#include <hip/hip_cooperative_groups.h>
#include <cstdio>
#include <cstdint>
namespace cg = cooperative_groups;

typedef unsigned short u16;
typedef __attribute__((ext_vector_type(8))) short bf16x8;
typedef __attribute__((ext_vector_type(16))) float f32x16;
typedef __attribute__((ext_vector_type(4))) unsigned u32x4;

#ifndef MULTI_LAUNCH
#define MULTI_LAUNCH 0
#endif

#ifndef DUP_MASK
#define DUP_MASK 0
#endif
#define HALF_LDS 67584
#define FOR_ITEMS(total, it) for (int _hb = tidx_opaque() >> 8, _j = blockIdx.x, it = 2 * _j + _hb; 2 * _j < (total); _j += gridDim.x, it = 2 * _j + _hb)
constexpr int NTOK = 8704;
constexpr int ABN = 5216;
constexpr int FFN = 5632;
constexpr int NPHASE = 22;
constexpr int O_KP = 17825792, O_VP = 19922944, O_KIP = 22020096, O_SSMP = 22544384, O_SSMCP = 22806528,
              O_LRUP = 22815744, O_LRUCP = 22819840, O_KS = 22832128, O_VS = 22963200, O_KIS = 23094272,
              O_SSMS = 23127040, O_SSMCS = 25224192, O_LRUS = 25297920, O_LRUCS = 25330688;

struct Params {
  const float *x_prompt, *x_sample, *cache_k, *cache_v, *cache_ki, *state_ssm, *state_ssm_conv, *state_lru,
      *state_lru_conv, *c_prompt, *c_sample;
  const float *ada_w, *ada_b, *norm_mix_w, *norm_ffn_w, *w_in_ab, *q_norm_w, *k_norm_w, *ssd_conv_w, *ssd_conv_b,
      *ssd_dt_bias, *ssd_a_log, *ssd_d, *ssd_norm_w, *w_out_ab, *w_in_c, *lru_conv_w, *lru_conv_b, *lru_w_a,
      *lru_b_a, *lru_w_x, *lru_b_x, *lru_lambda, *w_out_c, *ffn_w_gate, *ffn_w_up, *ffn_w_down;
  float* out;
  u16 *Wt_in_ab, *Wt_out_ab, *Wt_gu, *Wt_down, *Wt_in_c, *Wt_ax, *Wt_out_c;
  float* mod;
  float* modp;
  u16* Abuf;
  float* R1;
  float* R2;
  float* xcur;
  u16 *qb, *qib;
  float* wi;
  u16 *Kb, *Vb, *kib;
  float *xs, *bm, *cm, *dt, *cumb;
  int* sel;
  float *aggA, *aggU;
  unsigned* bar;
};

typedef const __attribute__((address_space(4))) Params* cparams_t;
__device__ __forceinline__ const Params& opaque_params(const Params& p0) {
  cparams_t q = (cparams_t)__builtin_amdgcn_kernarg_segment_ptr();
  asm volatile("" : "+s"(q));
  return *(const Params*)q;
}
__device__ __forceinline__ int tidx_opaque() {
  int t = threadIdx.x;
  asm volatile("" : "+v"(t));
  return t;
}
__device__ __forceinline__ u16 f2bf(float f) {
  unsigned u = __float_as_uint(f);
  u += 0x7fffu + ((u >> 16) & 1u);
  return (u16)(u >> 16);
}
__device__ __forceinline__ unsigned pack2(float a, float b) { return (unsigned)f2bf(a) | ((unsigned)f2bf(b) << 16); }
__device__ __forceinline__ float bf2f(u16 h) { return __uint_as_float((unsigned)h << 16); }
__device__ __forceinline__ float bflo(unsigned u) { return __uint_as_float(u << 16); }
__device__ __forceinline__ float bfhi(unsigned u) { return __uint_as_float(u & 0xffff0000u); }
__device__ __forceinline__ float wave_sum(float v) {
#pragma unroll
  for (int o = 32; o > 0; o >>= 1) v += __shfl_xor(v, o);
  return v;
}
__device__ __forceinline__ float wave_max(float v) {
#pragma unroll
  for (int o = 32; o > 0; o >>= 1) v = fmaxf(v, __shfl_xor(v, o));
  return v;
}
__device__ __forceinline__ float siluf_(float x) { return x / (1.f + __expf(-x)); }
__device__ __forceinline__ void tok_info(int tok, int& seq, int& t, int& pos, int& T) {
  if (tok < 8192) { seq = tok >> 12; t = tok & 4095; pos = t; T = 4096; }
  else { int r = tok - 8192; seq = 2 + (r >> 5); t = r & 31; pos = 1024 + t; T = 32; }
}
__device__ __forceinline__ int tok_seq(int tok) { return tok < 8192 ? (tok >> 12) : 2 + ((tok - 8192) >> 5); }
__device__ __forceinline__ int kv_base(int seq) { return seq < 2 ? seq * 4096 : 8192 + (seq - 2) * 1056; }
__device__ __forceinline__ const float* xin_row(const Params& p, int tok) {
  return tok < 8192 ? p.x_prompt + (size_t)tok * 2048 : p.x_sample + (size_t)(tok - 8192) * 2048;
}
__device__ __forceinline__ void rope_cs(float fpos, int i, float inv_half, float& c, float& s) {
  float inv = exp2f(-(float)i * inv_half * 13.287712379549449f);
  float ang = fpos * inv;
  float rev = ang * 0.15915494309189535f;
  rev -= floorf(rev);
  c = __builtin_amdgcn_cosf(rev);
  s = __builtin_amdgcn_sinf(rev);
}
__device__ __forceinline__ f32x16 zero16() {
  f32x16 z;
#pragma unroll
  for (int i = 0; i < 16; ++i) z[i] = 0.f;
  return z;
}

__device__ __forceinline__ void ada_item(const Params& p, int item, float* sm) {
  const int kc = item & 3, rest = item >> 2;
  const int l = rest / 192, slab = rest % 192;
  const int tid = (tidx_opaque() & 255), cl = tid & 15, kg = tid >> 4;
  float acc[18][4];
#pragma unroll
  for (int s = 0; s < 18; ++s) { acc[s][0] = acc[s][1] = acc[s][2] = acc[s][3] = 0.f; }
  const float* W = p.ada_w + (size_t)l * 2048 * 12288 + (size_t)(kc * 512) * 12288 + slab * 64 + cl * 4;
  for (int i = tid; i < 18 * 512; i += 256) {
    int s = i >> 9, k = i & 511;
    float c = s < 2 ? p.c_prompt[s * 2048 + kc * 512 + k] : p.c_sample[(s - 2) * 2048 + kc * 512 + k];
    sm[i] = c / (1.f + expf(-c));
  }
  __syncthreads();
#pragma unroll 8
  for (int kk = kg; kk < 512; kk += 16) {
    float4 w = *(const float4*)(W + (size_t)kk * 12288);
#pragma unroll
    for (int s = 0; s < 18; ++s) {
      float c = sm[s * 512 + kk];
      acc[s][0] += c * w.x; acc[s][1] += c * w.y; acc[s][2] += c * w.z; acc[s][3] += c * w.w;
    }
  }
#pragma unroll
  for (int s = 0; s < 18; ++s)
#pragma unroll
    for (int j = 0; j < 4; ++j) {
      float v = acc[s][j];
      v += __shfl_xor(v, 16);
      v += __shfl_xor(v, 32);
      acc[s][j] = v;
    }
  __syncthreads();
  const int wave = tid >> 6, lane = tid & 63;
  if (lane < 16) {
#pragma unroll
    for (int s = 0; s < 18; ++s)
#pragma unroll
      for (int j = 0; j < 4; ++j) sm[(wave * 72 + s * 4 + j) * 16 + lane] = acc[s][j];
  }
  __syncthreads();
  for (int i = tid; i < 1152; i += 256) {
    int sj = i >> 4, c = i & 15;
    float v = sm[(0 * 72 + sj) * 16 + c] + sm[(1 * 72 + sj) * 16 + c] + sm[(2 * 72 + sj) * 16 + c] + sm[(3 * 72 + sj) * 16 + c];
    int s = sj >> 2, j = sj & 3;
    int col = slab * 64 + c * 4 + j;
    p.modp[(size_t)((kc * 2 + l) * 18 + s) * 12288 + col] = v;
  }
  __syncthreads();
}

__device__ __forceinline__ void conv_tile(const float* src, int ldn, int K, int Nvalid, int Nstore, int kt, int nt, u16* dst, int mode, float* sm) {
  const int tid = (tidx_opaque() & 255);
  float4 v[16];
#pragma unroll
  for (int i = 0; i < 16; ++i) {
    int idx = tid + 256 * i;
    int kk = idx >> 6, c4 = idx & 63;
    int n = nt * 256 + c4 * 4;
    v[i] = make_float4(0.f, 0.f, 0.f, 0.f);
    if (n < Nvalid) v[i] = *(const float4*)(src + (size_t)(kt * 64 + kk) * ldn + n);
  }
#pragma unroll
  for (int i = 0; i < 16; ++i) {
    int idx = tid + 256 * i;
    int kk = idx >> 6, c4 = idx & 63;
    float* d = sm + kk * 257 + c4 * 4;
    d[0] = v[i].x; d[1] = v[i].y; d[2] = v[i].z; d[3] = v[i].w;
  }
  __syncthreads();
#pragma unroll
  for (int i = 0; i < 8; ++i) {
    int idx = tid + 256 * i;
    int nn = idx >> 3, kc = idx & 7;
    const float* s = sm + (kc * 8) * 257 + nn;
    uint4 o;
    o.x = pack2(s[0 * 257], s[1 * 257]);
    o.y = pack2(s[2 * 257], s[3 * 257]);
    o.z = pack2(s[4 * 257], s[5 * 257]);
    o.w = pack2(s[6 * 257], s[7 * 257]);
    int n = nt * 256 + nn;
    int r = (mode == 0) ? n : (64 * (n >> 5) + (n & 31) + (mode == 2 ? 32 : 0));
    if (n < Nstore) *(uint4*)(dst + (size_t)r * K + kt * 64 + kc * 8) = o;
  }
  __syncthreads();
}

__device__ __forceinline__ void conv_item(const Params& p, int i, float* sm) {
  if (i < 672) { conv_tile(p.w_in_ab, 5216, 2048, 5216, 5376, i / 21, i % 21, p.Wt_in_ab, 0, sm); return; }
  i -= 672;
  if (i < 256) { conv_tile(p.w_out_ab, 2048, 2048, 2048, 2048, i >> 3, i & 7, p.Wt_out_ab, 0, sm); return; }
  i -= 256;
  if (i < 1408) { int l = i / 704, r = i % 704;
    conv_tile(p.ffn_w_gate + (size_t)l * 2048 * 5632, 5632, 2048, 5632, 5632, r / 22, r % 22, p.Wt_gu + (size_t)l * 11264 * 2048, 1, sm); return; }
  i -= 1408;
  if (i < 1408) { int l = i / 704, r = i % 704;
    conv_tile(p.ffn_w_up + (size_t)l * 2048 * 5632, 5632, 2048, 5632, 5632, r / 22, r % 22, p.Wt_gu + (size_t)l * 11264 * 2048, 2, sm); return; }
  i -= 1408;
  if (i < 1408) { int l = i / 704, r = i % 704;
    conv_tile(p.ffn_w_down + (size_t)l * 5632 * 2048, 2048, 5632, 2048, 2048, r >> 3, r & 7, p.Wt_down + (size_t)l * 2048 * 5632, 0, sm); return; }
  i -= 1408;
  if (i < 512) { conv_tile(p.w_in_c, 4096, 2048, 4096, 4096, i >> 4, i & 15, p.Wt_in_c, 0, sm); return; }
  i -= 512;
  if (i < 256) { conv_tile(p.w_out_c, 2048, 2048, 2048, 2048, i >> 3, i & 7, p.Wt_out_c, 0, sm); return; }
  i -= 256;
  if (i < 32) { int kb = i >> 1, kt = i & 1;
    conv_tile(p.lru_w_a + kb * 16384, 128, 128, 128, 128, kt, 0, p.Wt_ax + kb * 32768, 1, sm); return; }
  i -= 32;
  { int kb = i >> 1, kt = i & 1;
    conv_tile(p.lru_w_x + kb * 16384, 128, 128, 128, 128, kt, 0, p.Wt_ax + kb * 32768, 2, sm); }
}

__device__ __forceinline__ void cache_item(const Params& p, int i) {
  const int tid = (tidx_opaque() & 255);
  const float* src; u16* dst; int rowlen;
  if (i < 2048) { src = p.cache_k; dst = p.Kb; rowlen = 256; }
  else if (i < 4096) { i -= 2048; src = p.cache_v; dst = p.Vb; rowlen = 256; }
  else { i -= 4096; src = p.cache_ki; dst = p.kib; rowlen = 64; }
  int e = i * 2048 + tid * 8;
  int row = e / rowlen, col = e % rowlen;
  int b = row >> 10, pos = row & 1023;
  float4 v0 = *(const float4*)(src + e), v1 = *(const float4*)(src + e + 4);
  uint4 o;
  o.x = pack2(v0.x, v0.y); o.y = pack2(v0.z, v0.w); o.z = pack2(v1.x, v1.y); o.w = pack2(v1.z, v1.w);
  *(uint4*)(dst + (size_t)(8192 + b * 1056 + pos) * rowlen + col) = o;
}

__device__ __forceinline__ float4 ld4sum(const float* base, size_t stride, const float* bias) {
  float4 a = *(const float4*)base, b = *(const float4*)(base + stride), c = *(const float4*)(base + 2 * stride),
         d = *(const float4*)(base + 3 * stride), e = *(const float4*)bias;
  return make_float4(a.x + b.x + c.x + d.x + e.x, a.y + b.y + c.y + d.y + e.y, a.z + b.z + c.z + d.z + e.z, a.w + b.w + c.w + d.w + e.w);
}
template <bool PARTIAL>
__device__ __forceinline__ void phase_normmod(const Params& p, const float* xsrc, const float* nw, const float* modl, int sh_off, int sc_off) {
  const int lane = (tidx_opaque() & 255) & 63, wave = (tidx_opaque() & 255) >> 6;
  FOR_ITEMS(NTOK / 4 + (PARTIAL ? 432 : 0), it) {
    if (PARTIAL && it >= NTOK / 4) {
      int e = ((it - NTOK / 4) * 256 + (tidx_opaque() & 255)) * 4;
      int col = e % 12288, l = e / (18 * 12288);
      *(float4*)(p.mod + e) = ld4sum(p.modp + e, (size_t)2 * 18 * 12288, p.ada_b + l * 12288 + col);
      continue;
    }
    int tok = it * 4 + wave;
    const float* xr = xsrc ? xsrc + (size_t)tok * 2048 : xin_row(p, tok);
    const float* md = modl + (size_t)tok_seq(tok) * 12288;
    float4 v[8], wv[8], scv[8], shv[8];
    float ss = 0.f;
#pragma unroll
    for (int i = 0; i < 8; ++i) v[i] = *(const float4*)(xr + i * 256 + lane * 4);
#pragma unroll
    for (int i = 0; i < 8; ++i) {
      int c = i * 256 + lane * 4;
      wv[i] = *(const float4*)(nw + c);
      if (PARTIAL) {
        scv[i] = ld4sum(md + sc_off + c, (size_t)2 * 18 * 12288, p.ada_b + sc_off + c);
        shv[i] = ld4sum(md + sh_off + c, (size_t)2 * 18 * 12288, p.ada_b + sh_off + c);
      } else {
        scv[i] = *(const float4*)(md + sc_off + c);
        shv[i] = *(const float4*)(md + sh_off + c);
      }
    }
#pragma unroll
    for (int i = 0; i < 8; ++i) ss += v[i].x * v[i].x + v[i].y * v[i].y + v[i].z * v[i].z + v[i].w * v[i].w;
    ss = wave_sum(ss);
    float rn = rsqrtf(ss * (1.f / 2048.f) + 1e-6f);
#pragma unroll
    for (int i = 0; i < 8; ++i) {
      int c = i * 256 + lane * 4;
      const float4 w = wv[i], sc = scv[i], sh = shv[i];
      float a0 = v[i].x * rn * w.x * (1.f + sc.x) + sh.x;
      float a1 = v[i].y * rn * w.y * (1.f + sc.y) + sh.y;
      float a2 = v[i].z * rn * w.z * (1.f + sc.z) + sh.z;
      float a3 = v[i].w * rn * w.w * (1.f + sc.w) + sh.w;
      uint2 o; o.x = pack2(a0, a1); o.y = pack2(a2, a3);
      *(uint2*)(p.Abuf + (size_t)tok * 2048 + c) = o;
    }
  }
}

enum { EPI_F32 = 0, EPI_RESID = 1, EPI_SWIGLU = 2, EPI_LRU = 3 };
struct GemmArgs {
  const u16* A; int lda; const u16* B; int K; int ntn; int ntiles;
  float* C; int ldc; int nvalid;
  const float* xin; float* xout; const float* gate;
  u16* H;
};
typedef __attribute__((ext_vector_type(4))) float f32x4;
__device__ __forceinline__ int lds_byte(int r, int c) {
  int st = (r >> 4) * 2 + (c >> 5), ob = (r & 15) * 64 + (c & 31) * 2;
  return st * 1024 + (ob ^ (((ob >> 9) & 1) << 5));
}
__device__ __forceinline__ void stage_rc(int b, int& R, int& C) {
  int st = b >> 10, sb = b & 1023, swz = sb ^ (((sb >> 9) & 1) << 5);
  R = (st >> 1) * 16 + swz / 64;
  C = (st & 1) * 32 + (swz % 64) / 2;
}
#define WAIT_V0() asm volatile("s_waitcnt vmcnt(0)" ::: "memory")
typedef const __attribute__((address_space(1))) unsigned* gptr_t;
typedef __attribute__((address_space(3))) unsigned* lptr_t;

template <int EPI, int CFG>
__device__ __forceinline__ void gemm_phase(const Params& p, const GemmArgs& g, char* smem) {
  constexpr int WC = (CFG == 1) ? 2 : 4;
  constexpr int NF = 4;
  constexpr int MF = (CFG == 0) ? 8 : (CFG == 1 ? 4 : 9);
  constexpr int BM = (CFG == 2) ? 272 : 256;
  constexpr int BN = WC * NF * 16;
  constexpr int NSUBA = BM / 16 * 2;
  constexpr int OFF_B = NSUBA * 1024;
  constexpr int STAGE_B = OFF_B + 32768;
  constexpr int GLA = (NSUBA + 7) / 8;
  constexpr int GLB = BN * 128 / 8192;
  constexpr int WROWS = (CFG == 2) ? 144 : MF * 16;
  constexpr int ntm = (CFG == 2) ? 32 : 34;
  const int tid = tidx_opaque(), wid = tid >> 6, lane = tid & 63, wr = wid / WC, wc = wid % WC, fr = lane & 15, fq = lane >> 4;
  const bool mlast = (CFG != 2) || (wr == 0);
  int sR[GLA], sC[GLA];
#pragma unroll
  for (int i = 0; i < GLA; ++i) stage_rc(wid * 1024 + i * 8192 + lane * 16, sR[i], sC[i]);
  const int nk = g.K >> 6;
  const int G = gridDim.x;
  const int bperm = (blockIdx.x & 7) * (G >> 3) + (blockIdx.x >> 3);
#define TILE_COORDS(lin_, mt_, nt_, Ab_, Bb_)                                                                         \
  do {                                                                                                                \
    if (EPI == EPI_LRU) {                                                                                             \
      mt_ = (lin_) >> 5; nt_ = (lin_) & 31;                                                                           \
      Ab_ = g.A + (size_t)mt_ * 256 * g.lda + (nt_ >> 1) * 128;                                                       \
      Bb_ = g.B + (size_t)nt_ * 128 * 128;                                                                            \
    } else {                                                                                                          \
      const int nig_ = 8 * g.ntn, gid_ = (lin_) / nig_, fm_ = gid_ * 8, gsz_ = min(ntm - fm_, 8), rem_ = (lin_) - gid_ * nig_; \
      mt_ = fm_ + rem_ % gsz_; nt_ = rem_ / gsz_;                                                                     \
      Ab_ = g.A + (size_t)mt_ * BM * g.lda;                                                                           \
      Bb_ = g.B + (size_t)nt_ * BN * g.K;                                                                             \
    }                                                                                                                 \
  } while (0)
#define GLDS_STAGE_P(buf, kt, Ap_, Bp_)                                                                              \
  do {                                                                                                                \
    _Pragma("unroll") for (int i = 0; i < GLA; ++i)                                                                   \
        if (i * 8 + 7 < NSUBA || wid + i * 8 < NSUBA)                                                                 \
          __builtin_amdgcn_global_load_lds((gptr_t)((Ap_) + (size_t)sR[i] * g.lda + (kt) * 64 + sC[i]),               \
                                           (lptr_t)(smem + (buf) * STAGE_B + wid * 1024 + i * 8192), 16, 0, 0);        \
    _Pragma("unroll") for (int i = 0; i < GLB; ++i)                                                                   \
        __builtin_amdgcn_global_load_lds((gptr_t)((Bp_) + (size_t)sR[i] * g.K + (kt) * 64 + sC[i]),                   \
                                         (lptr_t)(smem + (buf) * STAGE_B + OFF_B + wid * 1024 + i * 8192), 16, 0, 0);  \
  } while (0)
#define GLDS_STAGE(buf, kt) GLDS_STAGE_P(buf, kt, Ab, Bb)
  constexpr bool SEAM = (EPI != EPI_LRU);
  int mt = 0, nt = 0;
  const u16 *Ab = g.A, *Bb = g.B;
  if (bperm < g.ntiles) { TILE_COORDS(bperm, mt, nt, Ab, Bb); if (SEAM) GLDS_STAGE(0, 0); }
  for (int base = 0; base < g.ntiles; base += G) {
    const int lin = base + bperm;
    if (lin >= g.ntiles) continue;
    const int brow = mt * BM, bcol = nt * BN;
    f32x4 acc[MF][NF];
#pragma unroll
    for (int m = 0; m < MF; ++m)
#pragma unroll
      for (int n = 0; n < NF; ++n) { acc[m][n][0] = 0.f; acc[m][n][1] = 0.f; acc[m][n][2] = 0.f; acc[m][n][3] = 0.f; }
    if (!SEAM) GLDS_STAGE(0, 0);
    WAIT_V0();
    __syncthreads();
#pragma unroll 1
    for (int t = 0; t < nk; ++t) {
      const int cur = t & 1;
      if (t + 1 < nk) GLDS_STAGE(cur ^ 1, t + 1);
      const char* sa = smem + cur * STAGE_B;
      const char* sb = sa + OFF_B;
#pragma unroll
      for (int ks = 0; ks < 2; ++ks) {
        bf16x8 Bf[NF];
#pragma unroll
        for (int n = 0; n < NF; ++n) Bf[n] = *(const bf16x8*)(sb + lds_byte(wc * (NF * 16) + n * 16 + fr, ks * 32 + fq * 8));
        if (CFG == 2) {
#pragma unroll
          for (int mb = 0; mb < 9; mb += 3) {
            bf16x8 At[3];
#pragma unroll
            for (int m = 0; m < 3; ++m)
              if (mb + m < 8 || mlast) At[m] = *(const bf16x8*)(sa + lds_byte(wr * WROWS + (mb + m) * 16 + fr, ks * 32 + fq * 8));
            __builtin_amdgcn_s_setprio(1);
#pragma unroll
            for (int m = 0; m < 3; ++m)
              if (mb + m < 8 || mlast) {
#pragma unroll
                for (int n = 0; n < NF; ++n) acc[mb + m][n] = __builtin_amdgcn_mfma_f32_16x16x32_bf16(At[m], Bf[n], acc[mb + m][n], 0, 0, 0);
              }
            __builtin_amdgcn_s_setprio(0);
          }
        } else {
          bf16x8 At[MF];
#pragma unroll
          for (int m = 0; m < MF; ++m) At[m] = *(const bf16x8*)(sa + lds_byte(wr * WROWS + m * 16 + fr, ks * 32 + fq * 8));
          __builtin_amdgcn_s_setprio(1);
#pragma unroll
          for (int m = 0; m < MF; ++m)
#pragma unroll
            for (int n = 0; n < NF; ++n) acc[m][n] = __builtin_amdgcn_mfma_f32_16x16x32_bf16(At[m], Bf[n], acc[m][n], 0, 0, 0);
        }
        __builtin_amdgcn_s_setprio(0);
      }
      WAIT_V0();
      __syncthreads();
    }
    const int nt_cur = nt, mt_cur = mt;
    {
      const int nlin = lin + G;
      if (nlin < g.ntiles) { TILE_COORDS(nlin, mt, nt, Ab, Bb); if (SEAM) GLDS_STAGE(0, 0); }
    }
    const int rb = brow + wr * WROWS + fq * 4;
    const int cb = bcol + wc * (NF * 16) + fr;
    if (EPI == EPI_F32) {
#pragma unroll
      for (int n = 0; n < NF; ++n) {
        int col = cb + n * 16;
        if (col < g.nvalid) {
#pragma unroll
          for (int m = 0; m < MF; ++m)
            if (m < 8 || mlast) {
#pragma unroll
              for (int j = 0; j < 4; ++j) g.C[(size_t)(rb + m * 16 + j) * g.ldc + col] = acc[m][n][j];
            }
        }
      }
    } else if (EPI == EPI_RESID) {
#pragma unroll
      for (int m = 0; m < MF; ++m)
        if (m < 8 || mlast) {
          float xv[4][NF], gv[4][NF];
#pragma unroll
          for (int j = 0; j < 4; ++j) {
            int row = rb + m * 16 + j;
            const float* __restrict__ gp = g.gate + (size_t)tok_seq(row) * 12288;
            const float* __restrict__ xi = g.xin ? g.xin + (size_t)row * 2048 : xin_row(p, row);
#pragma unroll
            for (int n = 0; n < NF; ++n) { xv[j][n] = xi[cb + n * 16]; gv[j][n] = gp[cb + n * 16]; }
          }
#pragma unroll
          for (int j = 0; j < 4; ++j) {
            float* xo = g.xout + (size_t)(rb + m * 16 + j) * 2048;
#pragma unroll
            for (int n = 0; n < NF; ++n) xo[cb + n * 16] = xv[j][n] + gv[j][n] * acc[m][n][j];
          }
        }
    } else if (EPI == EPI_SWIGLU) {
      const int f0 = ((bcol + wc * 64) >> 1) + fr;
#pragma unroll
      for (int m = 0; m < MF; ++m)
#pragma unroll
        for (int j = 0; j < 4; ++j) {
          int row = rb + m * 16 + j;
#pragma unroll
          for (int n = 0; n < 2; ++n) g.H[(size_t)row * FFN + f0 + n * 16] = f2bf(siluf_(acc[m][n][j]) * acc[m][n + 2][j]);
        }
    } else {
      float* abuf = p.R2;
      float* ubuf = p.R2 + (size_t)NTOK * 2048;
      float xcv[2][MF][4];
#pragma unroll
      for (int n = 0; n < 2; ++n)
#pragma unroll
        for (int m = 0; m < MF; ++m)
#pragma unroll
          for (int j = 0; j < 4; ++j) xcv[n][m][j] = ubuf[(size_t)(rb + m * 16 + j) * 2048 + nt_cur * 64 + wc * 32 + n * 16 + fr];
      float aggA_w[2], aggU_w[2];
#pragma unroll
      for (int n = 0; n < 2; ++n) {
        const int ch = nt_cur * 64 + wc * 32 + n * 16 + fr;
        const float ba = p.lru_b_a[ch], bx = p.lru_b_x[ch];
        const float sp = log1pf(expf(-p.lru_lambda[ch]));
        float Aw = 1.f, Uw = 0.f;
#pragma unroll
        for (int m = 0; m < MF; ++m) {
          float Al = 1.f, Ul = 0.f;
#pragma unroll
          for (int j = 0; j < 4; ++j) {
            int row = rb + m * 16 + j;
            float rr = 1.f / (1.f + expf(-(acc[m][n][j] + ba)));
            float ii = 1.f / (1.f + expf(-(acc[m][n + 2][j] + bx)));
            float la = -8.f * rr * sp;
            float av = expf(la);
            float mult = sqrtf(-expm1f(2.f * la));
            float uv = mult * ii * xcv[n][m][j];
            size_t o = (size_t)row * 2048 + ch;
            abuf[o] = av;
            ubuf[o] = uv;
            Ul = av * Ul + uv; Al *= av;
          }
          {
            float Ap = __shfl_xor(Al, 16), Up = __shfl_xor(Ul, 16);
            if ((fq & 1) == 0) { Ul = Ap * Ul + Up; Al = Ap * Al; } else { Ul = Al * Up + Ul; Al = Al * Ap; }
            Ap = __shfl_xor(Al, 32); Up = __shfl_xor(Ul, 32);
            if ((fq & 2) == 0) { Ul = Ap * Ul + Up; Al = Ap * Al; } else { Ul = Al * Up + Ul; Al = Al * Ap; }
          }
          Uw = Al * Uw + Ul; Aw = Al * Aw;
        }
        aggA_w[n] = Aw; aggU_w[n] = Uw;
      }
      {
        float* sg = (float*)smem;
        if (fq == 0) {
#pragma unroll
          for (int n = 0; n < 2; ++n) { float* d = sg + ((((wr * 2 + wc) * 2 + n) * 16 + fr) << 1); d[0] = aggA_w[n]; d[1] = aggU_w[n]; }
        }
        __syncthreads();
        if (mt_cur < 32 && tid < 128) {
          const int c2 = tid >> 6, rest = tid & 63, wc2 = rest >> 5, n2 = (rest >> 4) & 1, fr2 = rest & 15;
          const float* s0 = sg + (((((2 * c2) * 2 + wc2) * 2 + n2) * 16 + fr2) << 1);
          const float* s1 = sg + (((((2 * c2 + 1) * 2 + wc2) * 2 + n2) * 16 + fr2) << 1);
          const int ch2 = nt_cur * 64 + wc2 * 32 + n2 * 16 + fr2;
          const int chunk = mt_cur * 2 + c2;
          p.aggA[chunk * 2048 + ch2] = s1[0] * s0[0];
          p.aggU[chunk * 2048 + ch2] = s1[0] * s0[1] + s1[1];
        }
        __syncthreads();
      }
    }
  }
}

__device__ __forceinline__ void post_proj_item(const Params& p, int item) {
  const int tid = (tidx_opaque() & 255), lane = tid & 63, wave = tid >> 6;
  const int tokb = item * 2;
  int seq, t0, pos0, T;
  tok_info(tokb, seq, t0, pos0, T);
  const float* __restrict__ prb = p.R1 + (size_t)tokb * ABN;
  float q1[2][2], q2[2][2], kv1[2], kv2[2], i1[2][2], i2[2][2], m1[2], m2[2], u[2][6][4], cw[6][5];
#pragma unroll
  for (int k = 0; k < 2; ++k) {
    const float* __restrict__ pr = prb + k * ABN;
    const int t = t0 + k;
#pragma unroll
    for (int rd = 0; rd < 2; ++rd) { int h = rd * 4 + wave; q1[k][rd] = pr[h * 128 + lane]; q2[k][rd] = pr[h * 128 + 64 + lane]; }
    kv1[k] = pr[1024 + wave * 128 + lane]; kv2[k] = pr[1024 + wave * 128 + 64 + lane];
#pragma unroll
    for (int rd = 0; rd < 2; ++rd) { int pair = tid + 256 * rd; int h = pair >> 5, i = pair & 31; i1[k][rd] = pr[1536 + h * 64 + i]; i2[k][rd] = pr[1536 + h * 64 + 32 + i]; }
    m1[k] = 0.f; m2[k] = 0.f;
    if (tid < 32) { m1[k] = pr[2560 + tid]; m2[k] = pr[2560 + 32 + tid]; }
    else if (tid < 48) m1[k] = pr[2624 + (tid - 32)];
    else if (tid >= 64 && tid < 80) m1[k] = pr[5200 + (tid - 64)] + p.ssd_dt_bias[tid - 64];
#pragma unroll
    for (int i = 0; i < 6; ++i) {
      int c = tid + 256 * i;
#pragma unroll
      for (int d = 0; d < 4; ++d) {
        int tt = t - d;
        if (tt >= 0) u[k][i][d] = pr[3664 + c - d * ABN];
        else u[k][i][d] = seq < 2 ? 0.f : p.state_ssm_conv[((seq - 2) * 3 + (3 + tt)) * 1536 + c];
      }
    }
  }
#pragma unroll
  for (int i = 0; i < 6; ++i) {
    int c = tid + 256 * i;
    cw[i][0] = p.ssd_conv_w[c]; cw[i][1] = p.ssd_conv_w[1536 + c]; cw[i][2] = p.ssd_conv_w[2 * 1536 + c];
    cw[i][3] = p.ssd_conv_w[3 * 1536 + c]; cw[i][4] = p.ssd_conv_b[c];
  }
  const float qw1 = p.q_norm_w[lane], qw2 = p.q_norm_w[64 + lane], kw1 = p.k_norm_w[lane], kw2 = p.k_norm_w[64 + lane];
#pragma unroll
  for (int k = 0; k < 2; ++k) {
    const int tok = tokb + k, t = t0 + k, pos = pos0 + k;
    const int kvrow = kv_base(seq) + pos;
    const float fpos = (float)pos;
    float* kout = tok < 8192 ? p.out + O_KP + (size_t)tok * 256 : p.out + O_KS + (size_t)(tok - 8192) * 256;
    float* vout = tok < 8192 ? p.out + O_VP + (size_t)tok * 256 : p.out + O_VS + (size_t)(tok - 8192) * 256;
    float* kiout = tok < 8192 ? p.out + O_KIP + (size_t)tok * 64 : p.out + O_KIS + (size_t)(tok - 8192) * 64;
    float c64, s64;
    rope_cs(fpos, lane, 1.f / 64.f, c64, s64);
#pragma unroll
    for (int rd = 0; rd < 2; ++rd) {
      int h = rd * 4 + wave;
      float x1 = q1[k][rd], x2 = q2[k][rd];
      float ss = wave_sum(x1 * x1 + x2 * x2);
      float rn = rsqrtf(ss * (1.f / 128.f) + 1e-6f);
      x1 *= rn * qw1;
      x2 *= rn * qw2;
      u16* q = p.qb + ((size_t)tok * 8 + h) * 128;
      q[lane] = f2bf(x1 * c64 - x2 * s64);
      q[64 + lane] = f2bf(x1 * s64 + x2 * c64);
    }
    if (wave < 2) {
      int h = wave;
      float x1 = kv1[k], x2 = kv2[k];
      float ss = wave_sum(x1 * x1 + x2 * x2);
      float rn = rsqrtf(ss * (1.f / 128.f) + 1e-6f);
      x1 *= rn * kw1;
      x2 *= rn * kw2;
      float o1 = x1 * c64 - x2 * s64, o2 = x1 * s64 + x2 * c64;
      kout[h * 128 + lane] = o1; kout[h * 128 + 64 + lane] = o2;
      u16* kb = p.Kb + (size_t)kvrow * 256 + h * 128;
      kb[lane] = f2bf(o1); kb[64 + lane] = f2bf(o2);
    } else {
      int h = wave - 2;
      vout[h * 128 + lane] = kv1[k]; vout[h * 128 + 64 + lane] = kv2[k];
      u16* vb = p.Vb + (size_t)kvrow * 256 + h * 128;
      vb[lane] = f2bf(kv1[k]); vb[64 + lane] = f2bf(kv2[k]);
    }
#pragma unroll
    for (int rd = 0; rd < 2; ++rd) {
      int pair = tid + 256 * rd;
      int h = pair >> 5, i = pair & 31;
      float c, s;
      rope_cs(fpos, i, 1.f / 32.f, c, s);
      u16* q = p.qib + ((size_t)tok * 16 + h) * 64;
      q[i] = f2bf(i1[k][rd] * c - i2[k][rd] * s);
      q[32 + i] = f2bf(i1[k][rd] * s + i2[k][rd] * c);
    }
    if (tid < 32) {
      float c, s;
      rope_cs(fpos, tid, 1.f / 32.f, c, s);
      float o1 = m1[k] * c - m2[k] * s, o2 = m1[k] * s + m2[k] * c;
      kiout[tid] = o1; kiout[32 + tid] = o2;
      u16* kb = p.kib + (size_t)kvrow * 64;
      kb[tid] = f2bf(o1); kb[32 + tid] = f2bf(o2);
    } else if (tid < 48) {
      p.wi[tok * 16 + (tid - 32)] = m1[k] * (0.25f * 0.125f);
    } else if (tid >= 64 && tid < 80) {
      p.dt[tok * 16 + (tid - 64)] = m1[k] > 20.f ? m1[k] : log1pf(expf(m1[k]));
    }
#pragma unroll
    for (int i = 0; i < 6; ++i) {
      int c = tid + 256 * i;
      float o = cw[i][4] + cw[i][3] * u[k][i][0] + cw[i][2] * u[k][i][1] + cw[i][1] * u[k][i][2] + cw[i][0] * u[k][i][3];
      o = siluf_(o);
      if (c < 1024) p.xs[(size_t)tok * 1024 + c] = o;
      else if (c < 1280) p.bm[(size_t)tok * 256 + (c - 1024)] = o;
      else p.cm[(size_t)tok * 256 + (c - 1280)] = o;
      if (t >= T - 3) {
        int j = t - (T - 3);
        float* dst = seq < 2 ? p.out + O_SSMCP + (seq * 3 + j) * 1536 : p.out + O_SSMCS + ((seq - 2) * 3 + j) * 1536;
        dst[c] = u[k][i][0];
      }
    }
  }
}

__device__ __forceinline__ void idx_item(const Params& p, int item) {
  const int tid = (tidx_opaque() & 255), lane = tid & 63, wave = tid >> 6;
  const int tg = item >> 2, kq = item & 3;
  const int tok0 = tg * 16;
  int seq, t, pos, T;
  tok_info(tok0, seq, t, pos, T);
  const int nkeys = seq < 2 ? ((t >> 6) + 1) * 64 : 1056;
  const int kbeg = kq * 1024;
  const int kend = min(nkeys, kbeg + 1024);
  if (kbeg >= kend) return;
  const int tokw = tok0 + wave * 4;
  const int r = lane & 31, hh = lane >> 5;
  const int tk = (r >> 2) & 1, hd = (r & 3) + 4 * (r >> 3);
  bf16x8 a[2][4];
  float wv[2][16];
#pragma unroll
  for (int pr = 0; pr < 2; ++pr) {
#pragma unroll
    for (int ks = 0; ks < 4; ++ks)
      a[pr][ks] = *(const bf16x8*)(p.qib + ((size_t)(tokw + pr * 2 + tk) * 16 + hd) * 64 + ks * 16 + hh * 8);
    const float4* wp = (const float4*)(p.wi + (tokw + pr * 2 + hh) * 16);
#pragma unroll
    for (int q = 0; q < 4; ++q) { float4 w = wp[q]; wv[pr][q * 4] = w.x; wv[pr][q * 4 + 1] = w.y; wv[pr][q * 4 + 2] = w.z; wv[pr][q * 4 + 3] = w.w; }
  }
  const int kvb = kv_base(seq);
  float* score = p.R2;
  bf16x8 b[4];
#pragma unroll
  for (int ks = 0; ks < 4; ++ks) b[ks] = *(const bf16x8*)(p.kib + (size_t)(kvb + kbeg + r) * 64 + ks * 16 + hh * 8);
  for (int k0 = kbeg; k0 < kend; k0 += 32) {
    bf16x8 bn[4];
    const int kn = (k0 + 32 < kend) ? k0 + 32 : k0;
#pragma unroll
    for (int ks = 0; ks < 4; ++ks) bn[ks] = *(const bf16x8*)(p.kib + (size_t)(kvb + kn + r) * 64 + ks * 16 + hh * 8);
#pragma unroll
    for (int pr = 0; pr < 2; ++pr) {
      f32x16 acc = zero16();
#pragma unroll
      for (int ks = 0; ks < 4; ++ks) acc = __builtin_amdgcn_mfma_f32_32x32x16_bf16(a[pr][ks], b[ks], acc, 0, 0, 0);
      float sc = 0.f;
#pragma unroll
      for (int q = 0; q < 16; ++q) sc += wv[pr][q] * fmaxf(acc[q], 0.f);
      score[(size_t)(tokw + pr * 2 + hh) * 4096 + k0 + r] = sc;
    }
#pragma unroll
    for (int ks = 0; ks < 4; ++ks) b[ks] = bn[ks];
  }
}

__device__ __forceinline__ void ssd_decode(int it, int& seq, int& tok0, int& L, int& h) {
  if (it < 2048) { seq = it >> 10; int c = (it >> 4) & 63; h = it & 15; L = 64; tok0 = seq * 4096 + c * 64; }
  else { int r = it - 2048; int sq = r >> 4; h = r & 15; seq = 2 + sq; L = 32; tok0 = 8192 + sq * 32; }
}

__device__ __forceinline__ void ssd_s1_item(const Params& p, int it, float* sm) {
  const int tid = (tidx_opaque() & 255), lane = tid & 63, wave = tid >> 6;
  const int r = lane & 31, hh = lane >> 5;
  float* xw = sm;
  float* Bs = sm + 4096;
  float* s_cum = Bs + 8192;
  float* s_w = s_cum + 64;
  int seq, tok0, L, h;
  ssd_decode(it, seq, tok0, L, h);
  const int g = h >> 3;
  const float a_neg = -expf(p.ssd_a_log[h]);
  float4 xr[4], br[8];
#pragma unroll
  for (int i = 0; i < 4; ++i) {
    int idx4 = tid + 256 * i;
    int s = idx4 >> 4, c4 = idx4 & 15;
    xr[i] = make_float4(0.f, 0.f, 0.f, 0.f);
    if (s < L) xr[i] = *(const float4*)(p.xs + (size_t)(tok0 + s) * 1024 + h * 64 + c4 * 4);
  }
#pragma unroll
  for (int i = 0; i < 8; ++i) {
    int idx4 = tid + 256 * i;
    int s = idx4 >> 5, c4 = idx4 & 31;
    br[i] = make_float4(0.f, 0.f, 0.f, 0.f);
    if (s < L) br[i] = *(const float4*)(p.bm + (size_t)(tok0 + s) * 256 + g * 128 + c4 * 4);
  }
  if (wave == 0) {
    float dtv = lane < L ? p.dt[(tok0 + lane) * 16 + h] : 0.f;
    float v = dtv * a_neg;
#pragma unroll
    for (int o = 1; o < 64; o <<= 1) { float n = __shfl_up(v, o); if (lane >= o) v += n; }
    if (lane < L) p.cumb[(tok0 + lane) * 16 + h] = v;
    s_cum[lane] = v;
    float last = __shfl(v, L - 1);
    s_w[lane] = lane < L ? expf(last - v) * dtv : 0.f;
  }
  __syncthreads();
#pragma unroll
  for (int i = 0; i < 4; ++i) {
    int idx4 = tid + 256 * i;
    int s = idx4 >> 4, c4 = idx4 & 15;
    float w = s_w[s];
    *(float4*)(xw + s * 64 + c4 * 4) = make_float4(xr[i].x * w, xr[i].y * w, xr[i].z * w, xr[i].w * w);
  }
#pragma unroll
  for (int i = 0; i < 8; ++i) {
    int idx4 = tid + 256 * i;
    int s = idx4 >> 5, c4 = idx4 & 31;
    *(float4*)(Bs + s * 128 + c4 * 4) = br[i];
  }
  __syncthreads();
  const int pi = wave & 1, nj0 = (wave >> 1) * 2;
  f32x16 acc0 = zero16(), acc1 = zero16();
  for (int kb = 0; kb < L / 2; kb += 8) {
    float a[8], b0[8], b1[8];
#pragma unroll
    for (int q = 0; q < 8; ++q) {
      int k = 2 * (kb + q) + hh;
      a[q] = xw[k * 64 + pi * 32 + r];
      b0[q] = Bs[k * 128 + nj0 * 32 + r];
      b1[q] = Bs[k * 128 + nj0 * 32 + 32 + r];
    }
    __builtin_amdgcn_s_setprio(1);
#pragma unroll
    for (int q = 0; q < 8; ++q) {
      acc0 = __builtin_amdgcn_mfma_f32_32x32x2f32(a[q], b0[q], acc0, 0, 0, 0);
      acc1 = __builtin_amdgcn_mfma_f32_32x32x2f32(a[q], b1[q], acc1, 0, 0, 0);
    }
    __builtin_amdgcn_s_setprio(0);
  }
  const float declast = expf(s_cum[L - 1]);
  if (seq < 2) {
#pragma unroll
    for (int j = 0; j < 2; ++j) {
      const f32x16& a = j == 0 ? acc0 : acc1;
#pragma unroll
      for (int q = 0; q < 16; ++q) {
        int pp = pi * 32 + (q & 3) + 8 * (q >> 2) + 4 * hh;
        int n = (nj0 + j) * 32 + r;
        p.xcur[(size_t)it * 8192 + pp * 128 + n] = a[q];
      }
    }
  } else {
    const size_t ob = (size_t)((seq - 2) * 16 + h) * 8192;
    float h0v[2][16];
#pragma unroll
    for (int j = 0; j < 2; ++j)
#pragma unroll
      for (int q = 0; q < 16; ++q) {
        int pp = pi * 32 + (q & 3) + 8 * (q >> 2) + 4 * hh;
        h0v[j][q] = p.state_ssm[ob + pp * 128 + (nj0 + j) * 32 + r];
      }
#pragma unroll
    for (int j = 0; j < 2; ++j) {
      const f32x16& a = j == 0 ? acc0 : acc1;
#pragma unroll
      for (int q = 0; q < 16; ++q) {
        int pp = pi * 32 + (q & 3) + 8 * (q >> 2) + 4 * hh;
        p.out[O_SSMS + ob + pp * 128 + (nj0 + j) * 32 + r] = declast * h0v[j][q] + a[q];
      }
    }
  }
  __syncthreads();
}

__device__ __forceinline__ void ssd_s2_item(const Params& p, int it) {
  const int seq = it >> 9, h = (it >> 5) & 15, e = (it & 31) * 256 + (tidx_opaque() & 255);
  float* __restrict__ S = p.xcur + (size_t)(seq * 64 * 16 + h) * 8192 + e;
  const float* __restrict__ cum = p.cumb + (seq * 4096 + 63) * 16 + h;
  float hst = 0.f;
  for (int c0 = 0; c0 < 64; c0 += 8) {
    float tmp[8], dec[8];
#pragma unroll
    for (int i = 0; i < 8; ++i) { tmp[i] = S[(size_t)(c0 + i) * 16 * 8192]; dec[i] = cum[(c0 + i) * 64 * 16]; }
#pragma unroll
    for (int i = 0; i < 8; ++i) {
      S[(size_t)(c0 + i) * 16 * 8192] = hst;
      hst = expf(dec[i]) * hst + tmp[i];
    }
  }
  p.out[O_SSMP + (size_t)(seq * 16 + h) * 8192 + e] = hst;
}

__device__ __forceinline__ void ssd_s3_item(const Params& p, int it, float* sm) {
  const int tid = (tidx_opaque() & 255), lane = tid & 63, wave = tid >> 6;
  const int r = lane & 31, hh = lane >> 5;
  float* bufA = sm;
  float* bufB = sm + 4160;
  float* Wb = sm + 8320;
  float* xb = sm + 12480;
  float* s_cum = sm + 16576;
  float* s_dt = s_cum + 64;
  int seq, tok0, L, h;
  ssd_decode(it, seq, tok0, L, h);
  const int g = h >> 3;
  const int ti = wave >> 1, si = wave & 1, pi = wave & 1;
  const float* hprev = seq < 2 ? p.xcur + (size_t)it * 8192 : p.state_ssm + (size_t)((seq - 2) * 16 + h) * 8192;
  float4 cr[2][4], br[2][4], hr[2][4], xr[4];
  float zr[16];
#pragma unroll
  for (int nh = 0; nh < 2; ++nh)
#pragma unroll
    for (int i = 0; i < 4; ++i) {
      int idx4 = tid + 256 * i;
      int s = idx4 >> 4, c4 = idx4 & 15;
      cr[nh][i] = make_float4(0.f, 0.f, 0.f, 0.f);
      br[nh][i] = cr[nh][i];
      if (s < L) {
        cr[nh][i] = *(const float4*)(p.cm + (size_t)(tok0 + s) * 256 + g * 128 + nh * 64 + c4 * 4);
        br[nh][i] = *(const float4*)(p.bm + (size_t)(tok0 + s) * 256 + g * 128 + nh * 64 + c4 * 4);
      }
      hr[nh][i] = *(const float4*)(hprev + s * 128 + nh * 64 + c4 * 4);
    }
#pragma unroll
  for (int i = 0; i < 4; ++i) {
    int idx4 = tid + 256 * i;
    int s = idx4 >> 4, c4 = idx4 & 15;
    xr[i] = make_float4(0.f, 0.f, 0.f, 0.f);
    if (s < L) xr[i] = *(const float4*)(p.xs + (size_t)(tok0 + s) * 1024 + h * 64 + c4 * 4);
  }
#pragma unroll
  for (int q = 0; q < 16; ++q) {
    int t = ti * 32 + (q & 3) + 8 * (q >> 2) + 4 * hh;
    zr[q] = t < L ? p.R1[(size_t)(tok0 + t) * ABN + 2640 + h * 64 + pi * 32 + r] : 0.f;
  }
  if (tid < 64) {
    s_cum[tid] = tid < L ? p.cumb[(tok0 + tid) * 16 + h] : 0.f;
    s_dt[tid] = tid < L ? p.dt[(tok0 + tid) * 16 + h] : 0.f;
  }
#define ST4(dst, v) do { float* _d = (dst); _d[0] = (v).x; _d[1] = (v).y; _d[2] = (v).z; _d[3] = (v).w; } while (0)
#define MM32(acc, pa, pb)                                                        \
  for (int kb = 0; kb < 32; kb += 8) {                                           \
    float _a[8], _b[8];                                                          \
    _Pragma("unroll") for (int q = 0; q < 8; ++q) { _a[q] = (pa)[2 * (kb + q)]; _b[q] = (pb)[2 * (kb + q)]; } \
    __builtin_amdgcn_s_setprio(1);                                             \
    _Pragma("unroll") for (int q = 0; q < 8; ++q) acc = __builtin_amdgcn_mfma_f32_32x32x2f32(_a[q], _b[q], acc, 0, 0, 0); \
    __builtin_amdgcn_s_setprio(0);                                             \
  }
  f32x16 cb = zero16();
#pragma unroll
  for (int nh = 0; nh < 2; ++nh) {
#pragma unroll
    for (int i = 0; i < 4; ++i) {
      int idx4 = tid + 256 * i;
      int s = idx4 >> 4, c4 = idx4 & 15;
      ST4(bufA + s * 65 + c4 * 4, cr[nh][i]);
      ST4(bufB + s * 65 + c4 * 4, br[nh][i]);
    }
    __syncthreads();
    {
      const float* pa = bufA + (ti * 32 + r) * 65 + hh;
      const float* pb = bufB + (si * 32 + r) * 65 + hh;
      MM32(cb, pa, pb)
    }
    __syncthreads();
  }
  {
    const int s = si * 32 + r;
    const float cs = s_cum[s], ds = s_dt[s];
#pragma unroll
    for (int q = 0; q < 16; ++q) {
      int t = ti * 32 + (q & 3) + 8 * (q >> 2) + 4 * hh;
      float val = (s <= t) ? cb[q] * expf(s_cum[t] - cs) * ds : 0.f;
      Wb[t * 65 + s] = val;
    }
  }
#pragma unroll
  for (int i = 0; i < 4; ++i) {
    int idx4 = tid + 256 * i;
    int s = idx4 >> 4, c4 = idx4 & 15;
    *(float4*)(xb + s * 64 + c4 * 4) = xr[i];
  }
#pragma unroll
  for (int i = 0; i < 4; ++i) {
    int idx4 = tid + 256 * i;
    int s = idx4 >> 4, c4 = idx4 & 15;
    ST4(bufA + s * 65 + c4 * 4, cr[0][i]);
    ST4(bufB + s * 65 + c4 * 4, hr[0][i]);
  }
  __syncthreads();
  f32x16 y1 = zero16(), y2 = zero16();
  for (int kb = 0; kb < 32; kb += 8) {
    float a[8], b[8];
#pragma unroll
    for (int q = 0; q < 8; ++q) { a[q] = Wb[(ti * 32 + r) * 65 + 2 * (kb + q) + hh]; b[q] = xb[(2 * (kb + q) + hh) * 64 + pi * 32 + r]; }
    __builtin_amdgcn_s_setprio(1);
#pragma unroll
    for (int q = 0; q < 8; ++q) y1 = __builtin_amdgcn_mfma_f32_32x32x2f32(a[q], b[q], y1, 0, 0, 0);
    __builtin_amdgcn_s_setprio(0);
  }
  {
    const float* pa = bufA + (ti * 32 + r) * 65 + hh;
    const float* pb = bufB + (pi * 32 + r) * 65 + hh;
    MM32(y2, pa, pb)
  }
  __syncthreads();
#pragma unroll
  for (int i = 0; i < 4; ++i) {
    int idx4 = tid + 256 * i;
    int s = idx4 >> 4, c4 = idx4 & 15;
    ST4(bufA + s * 65 + c4 * 4, cr[1][i]);
    ST4(bufB + s * 65 + c4 * 4, hr[1][i]);
  }
  __syncthreads();
  {
    const float* pa = bufA + (ti * 32 + r) * 65 + hh;
    const float* pb = bufB + (pi * 32 + r) * 65 + hh;
    MM32(y2, pa, pb)
  }
  {
    const int pc = pi * 32 + r;
    const float Dh = p.ssd_d[h];
#pragma unroll
    for (int q = 0; q < 16; ++q) {
      int t = ti * 32 + (q & 3) + 8 * (q >> 2) + 4 * hh;
      if (t < L) {
        int tok = tok0 + t;
        float y = y1[q] + expf(s_cum[t]) * y2[q] + Dh * xb[t * 64 + pc];
        float z = zr[q];
        p.R2[(size_t)tok * 1024 + h * 64 + pc] = y * siluf_(z);
      }
    }
  }
#undef ST4
#undef MM32
  __syncthreads();
}

__device__ __forceinline__ void phase_ssdnorm(const Params& p) {
  const int lane = (tidx_opaque() & 255) & 63, wave = (tidx_opaque() & 255) >> 6;
  FOR_ITEMS(NTOK * 2 / 4, it) {
    int pair = it * 4 + wave;
    int tok = pair >> 1, g = pair & 1;
    const float* y = p.R2 + (size_t)tok * 1024 + g * 512 + lane * 8;
    float4 v0 = *(const float4*)y, v1 = *(const float4*)(y + 4);
    float ss = v0.x * v0.x + v0.y * v0.y + v0.z * v0.z + v0.w * v0.w + v1.x * v1.x + v1.y * v1.y + v1.z * v1.z + v1.w * v1.w;
    ss = wave_sum(ss);
    float rn = rsqrtf(ss * (1.f / 512.f) + 1e-6f);
    const float* w = p.ssd_norm_w + g * 512 + lane * 8;
    float4 w0 = *(const float4*)w, w1 = *(const float4*)(w + 4);
    uint4 o;
    o.x = pack2(v0.x * rn * w0.x, v0.y * rn * w0.y);
    o.y = pack2(v0.z * rn * w0.z, v0.w * rn * w0.w);
    o.z = pack2(v1.x * rn * w1.x, v1.y * rn * w1.y);
    o.w = pack2(v1.z * rn * w1.z, v1.w * rn * w1.w);
    *(uint4*)(p.Abuf + (size_t)tok * 2048 + 1024 + g * 512 + lane * 8) = o;
  }
}

__device__ __forceinline__ unsigned ord_u(float f) {
  unsigned u = __float_as_uint(f);
  return (u & 0x80000000u) ? ~u : (u | 0x80000000u);
}
template <int NREG>
__device__ __forceinline__ void topk_wave(const float* sc, int nkeys, int* selout, int lane) {
  unsigned v[NREG];
#pragma unroll
  for (int r = 0; r < NREG; ++r) {
    int key = r * 64 + lane;
    v[r] = key < nkeys ? ord_u(sc[key]) : 0u;
  }
  unsigned prefix = 0;
#pragma unroll 1
  for (int bit = 31; bit >= 0; --bit) {
    unsigned cand = prefix | (1u << bit);
    int cnt = 0;
#pragma unroll
    for (int r = 0; r < NREG; ++r) cnt += __popcll(__ballot(v[r] >= cand));
    if (cnt >= 256) prefix = cand;
  }
  int cgt = 0;
#pragma unroll
  for (int r = 0; r < NREG; ++r) cgt += __popcll(__ballot(v[r] > prefix));
  const int need = 256 - cgt;
  int base = 0, tie_taken = 0;
#pragma unroll
  for (int r = 0; r < NREG; ++r) {
    bool gt = v[r] > prefix, eq = v[r] == prefix;
    unsigned long long em = __ballot(eq);
    int erank = __builtin_amdgcn_mbcnt_hi((unsigned)(em >> 32), __builtin_amdgcn_mbcnt_lo((unsigned)em, 0));
    bool take = gt || (eq && (tie_taken + erank < need));
    tie_taken += __popcll(em);
    unsigned long long m = __ballot(take);
    int pos = base + __builtin_amdgcn_mbcnt_hi((unsigned)(m >> 32), __builtin_amdgcn_mbcnt_lo((unsigned)m, 0));
    if (take && pos < 256) selout[pos] = r * 64 + lane;
    base += __popcll(m);
  }
}

__device__ __forceinline__ void topk_item(const Params& p, int item) {
  const int lane = (tidx_opaque() & 255) & 63, wave = (tidx_opaque() & 255) >> 6;
  const int tok = item * 4 + wave;
  int seq, t, pos, T;
  tok_info(tok, seq, t, pos, T);
  const int nkeys = seq < 2 ? ((t >> 6) + 1) * 64 : 1056;
  int* so = p.sel + (size_t)tok * 256;
  const float* sc = p.R2 + (size_t)tok * 4096;
  if (nkeys <= 256) {
#pragma unroll
    for (int i = 0; i < 4; ++i) so[i * 64 + lane] = i * 64 + lane;
    return;
  }
  if (nkeys <= 1024) topk_wave<16>(sc, nkeys, so, lane);
  else if (nkeys <= 1088) topk_wave<17>(sc, nkeys, so, lane);
  else if (nkeys <= 2048) topk_wave<32>(sc, nkeys, so, lane);
  else topk_wave<64>(sc, nkeys, so, lane);
}

__device__ __forceinline__ void attn_item(const Params& p, int tok0, int g, char* smem) {
  const int tid = (tidx_opaque() & 255), lane = tid & 63, wave = tid >> 6;
  float* qs = (float*)smem + wave * 1792;
  float* ps = qs + 512;
  int* rows = (int*)(ps + 1024);
  const int tok = tok0 + wave;
  int seq, t, pos, T;
  tok_info(tok, seq, t, pos, T);
  const int nkeys = seq < 2 ? ((t >> 6) + 1) * 64 : 1056;
  const int nsel = min(nkeys, 256);
  const int nkb = nsel >> 4;
  const int kvb = kv_base(seq);
  const int c16 = lane & 15, q4 = lane >> 4;
  bf16x8 qa[4];
#pragma unroll
  for (int ks = 0; ks < 4; ++ks) {
#pragma unroll
    for (int e = 0; e < 8; ++e) qa[ks][e] = 0;
    if (c16 < 4) qa[ks] = *(const bf16x8*)(p.qb + ((size_t)tok * 8 + g * 4 + c16) * 128 + ks * 32 + q4 * 8);
  }
#pragma unroll
  for (int i = 0; i < 4; ++i) {
    int j = i * 64 + lane;
    int idx = (j < nsel) ? p.sel[(size_t)tok * 256 + j] : 0;
    rows[j] = kvb + idx;
  }
  __builtin_amdgcn_wave_barrier();
  f32x4 sacc[16];
#pragma unroll
  for (int kb = 0; kb < 16; ++kb) {
    sacc[kb][0] = -INFINITY; sacc[kb][1] = -INFINITY; sacc[kb][2] = -INFINITY; sacc[kb][3] = -INFINITY;
    if (kb < nkb) {
      const int row = rows[kb * 16 + c16];
      const u16* kp = p.Kb + (size_t)row * 256 + g * 128 + q4 * 8;
      bf16x8 b0 = *(const bf16x8*)(kp), b1 = *(const bf16x8*)(kp + 32), b2 = *(const bf16x8*)(kp + 64), b3 = *(const bf16x8*)(kp + 96);
      f32x4 acc = {0.f, 0.f, 0.f, 0.f};
      acc = __builtin_amdgcn_mfma_f32_16x16x32_bf16(qa[0], b0, acc, 0, 0, 0);
      acc = __builtin_amdgcn_mfma_f32_16x16x32_bf16(qa[1], b1, acc, 0, 0, 0);
      acc = __builtin_amdgcn_mfma_f32_16x16x32_bf16(qa[2], b2, acc, 0, 0, 0);
      acc = __builtin_amdgcn_mfma_f32_16x16x32_bf16(qa[3], b3, acc, 0, 0, 0);
      sacc[kb] = acc;
    }
  }
  const float scl = 0.08838834764831845f;
#pragma unroll
  for (int i = 0; i < 4; ++i) {
    float m = sacc[0][i];
#pragma unroll
    for (int kb = 1; kb < 16; ++kb) m = fmaxf(m, sacc[kb][i]);
#pragma unroll
    for (int o = 8; o > 0; o >>= 1) m = fmaxf(m, __shfl_xor(m, o));
    float sum = 0.f;
#pragma unroll
    for (int kb = 0; kb < 16; ++kb) { float e = __expf((sacc[kb][i] - m) * scl); sacc[kb][i] = e; sum += e; }
#pragma unroll
    for (int o = 8; o > 0; o >>= 1) sum += __shfl_xor(sum, o);
    const float inv = 1.f / sum;
#pragma unroll
    for (int kb = 0; kb < 16; ++kb) sacc[kb][i] *= inv;
  }
  if (q4 == 0) {
#pragma unroll
    for (int kb = 0; kb < 16; ++kb) *(f32x4*)(ps + (kb * 16 + c16) * 4) = sacc[kb];
  }
  __builtin_amdgcn_wave_barrier();
  float o[4][2];
#pragma unroll
  for (int r = 0; r < 4; ++r) o[r][0] = o[r][1] = 0.f;
  const u16* vbase = p.Vb + g * 128 + lane * 2;
  for (int j0 = 0; j0 < nsel; j0 += 64) {
    unsigned vv[64];
#pragma unroll
    for (int u = 0; u < 64; u += 4) {
      int4 r4 = *(const int4*)(rows + j0 + u);
      vv[u + 0] = *(const unsigned*)(vbase + (size_t)r4.x * 256);
      vv[u + 1] = *(const unsigned*)(vbase + (size_t)r4.y * 256);
      vv[u + 2] = *(const unsigned*)(vbase + (size_t)r4.z * 256);
      vv[u + 3] = *(const unsigned*)(vbase + (size_t)r4.w * 256);
    }
#pragma unroll
    for (int u = 0; u < 64; ++u) {
      float4 p4 = *(const float4*)(ps + (j0 + u) * 4);
      float v0 = bflo(vv[u]), v1 = bfhi(vv[u]);
      o[0][0] += p4.x * v0; o[0][1] += p4.x * v1;
      o[1][0] += p4.y * v0; o[1][1] += p4.y * v1;
      o[2][0] += p4.z * v0; o[2][1] += p4.z * v1;
      o[3][0] += p4.w * v0; o[3][1] += p4.w * v1;
    }
  }
#pragma unroll
  for (int r = 0; r < 4; ++r)
    *(unsigned*)(p.Abuf + (size_t)tok * 2048 + (g * 4 + r) * 128 + lane * 2) = pack2(o[r][0], o[r][1]);
  __builtin_amdgcn_wave_barrier();
}

__device__ __forceinline__ void lru_conv_item(const Params& p, int tok) {
  const int tid = (tidx_opaque() & 255);
  int seq, t, pos, T;
  tok_info(tok, seq, t, pos, T);
  const float* gx = p.R1 + (size_t)tok * 4096 + 2048;
  float* xcf = p.R2 + (size_t)NTOK * 2048 + (size_t)tok * 2048;
  float4 u[2][4], w[2][5];
#pragma unroll
  for (int i = 0; i < 2; ++i) {
    int c = (tid + 256 * i) * 4;
#pragma unroll
    for (int d = 0; d < 4; ++d) {
      int tt = t - d;
      if (tt >= 0) u[i][d] = *(const float4*)(gx + c - d * 4096);
      else if (seq < 2) u[i][d] = make_float4(0.f, 0.f, 0.f, 0.f);
      else u[i][d] = *(const float4*)(p.state_lru_conv + ((seq - 2) * 3 + (3 + tt)) * 2048 + c);
    }
    w[i][0] = *(const float4*)(p.lru_conv_w + c); w[i][1] = *(const float4*)(p.lru_conv_w + 2048 + c);
    w[i][2] = *(const float4*)(p.lru_conv_w + 2 * 2048 + c); w[i][3] = *(const float4*)(p.lru_conv_w + 3 * 2048 + c);
    w[i][4] = *(const float4*)(p.lru_conv_b + c);
  }
#pragma unroll
  for (int i = 0; i < 2; ++i) {
    int c = (tid + 256 * i) * 4;
    float4 o;
    o.x = w[i][4].x + w[i][3].x * u[i][0].x + w[i][2].x * u[i][1].x + w[i][1].x * u[i][2].x + w[i][0].x * u[i][3].x;
    o.y = w[i][4].y + w[i][3].y * u[i][0].y + w[i][2].y * u[i][1].y + w[i][1].y * u[i][2].y + w[i][0].y * u[i][3].y;
    o.z = w[i][4].z + w[i][3].z * u[i][0].z + w[i][2].z * u[i][1].z + w[i][1].z * u[i][2].z + w[i][0].z * u[i][3].z;
    o.w = w[i][4].w + w[i][3].w * u[i][0].w + w[i][2].w * u[i][1].w + w[i][1].w * u[i][2].w + w[i][0].w * u[i][3].w;
    *(float4*)(xcf + c) = o;
    uint2 ob; ob.x = pack2(o.x, o.y); ob.y = pack2(o.z, o.w);
    *(uint2*)(p.Abuf + (size_t)tok * 2048 + c) = ob;
    if (t >= T - 3) {
      int j = t - (T - 3);
      float* dst = seq < 2 ? p.out + O_LRUCP + (seq * 3 + j) * 2048 : p.out + O_LRUCS + ((seq - 2) * 3 + j) * 2048;
      *(float4*)(dst + c) = u[i][0];
    }
  }
}

__device__ __forceinline__ void lru_agg_item(const Params& p, int it) {
  const int chunk = it >> 3, ch = (it & 7) * 256 + (tidx_opaque() & 255);
  const float* ab = p.R2 + (size_t)chunk * 128 * 2048 + ch;
  const float* ub = ab + (size_t)NTOK * 2048;
  float A = 1.f, h = 0.f;
#pragma unroll 8
  for (int t = 0; t < 128; ++t) {
    float a = ab[(size_t)t * 2048], u = ub[(size_t)t * 2048];
    h = a * h + u;
    A *= a;
  }
  p.aggA[chunk * 2048 + ch] = A;
  p.aggU[chunk * 2048 + ch] = h;
}

__device__ __forceinline__ float gelu_tanh(float x) {
  float y = 0.7978845608028654f * (x + 0.044715f * x * x * x);
  float e = __expf(2.f * y);
  float th = 1.f - 2.f / (e + 1.f);
  return 0.5f * x * (1.f + th);
}

__device__ __forceinline__ void lru_scan_item(const Params& p, int it) {
  int tok0, L, seq;
  const int ch = (it & 7) * 256 + (tidx_opaque() & 255);
  float h;
  bool last;
  if (it < 512) {
    int chunk = it >> 3;
    seq = chunk >> 5;
    int cs = chunk & 31;
    tok0 = chunk * 128; L = 128;
    h = 0.f;
    {
      const float* __restrict__ gA = p.aggA + seq * 32 * 2048 + ch;
      const float* __restrict__ gU = p.aggU + seq * 32 * 2048 + ch;
#pragma unroll 8
      for (int c = 0; c < cs; ++c) h = gA[c * 2048] * h + gU[c * 2048];
    }
    last = cs == 31;
  } else {
    int sq = (it - 512) >> 3;
    seq = 2 + sq;
    tok0 = 8192 + sq * 32; L = 32;
    h = p.state_lru[sq * 2048 + ch];
    last = true;
  }
  const float* ab = p.R2 + (size_t)tok0 * 2048 + ch;
  const float* ub = ab + (size_t)NTOK * 2048;
  const float* gt = p.R1 + (size_t)tok0 * 4096 + ch;
  u16* yo = p.Abuf + (size_t)tok0 * 2048 + ch;
#pragma unroll 8
  for (int t = 0; t < L; ++t) {
    float a = ab[(size_t)t * 2048], u = ub[(size_t)t * 2048], gv = gt[(size_t)t * 4096];
    h = a * h + u;
    yo[(size_t)t * 2048] = f2bf(h * gelu_tanh(gv));
  }
  if (last) {
    if (seq < 2) p.out[O_LRUP + seq * 2048 + ch] = h;
    else p.out[O_LRUS + (seq - 2) * 2048 + ch] = h;
  }
}

#define XB_TMO      128
#define XB_XCNT(j)  (256  + 64 * (j))
#define XB_XSUB(j)  (1280 + 64 * (j))
#define XB_XGEN(j)  (2304 + 64 * (j))
#define XB_TOP      3328
#define XB_TOPGEN   3392
#define XCD_BAR_WORDS 3456
#define XB_SPIN_CAP (1u << 18)
#define LAS __attribute__((address_space(3)))
__device__ __forceinline__ unsigned xb_ld(unsigned* p)              { return __hip_atomic_load(p, __ATOMIC_RELAXED, __HIP_MEMORY_SCOPE_AGENT); }
__device__ __forceinline__ unsigned xb_add(unsigned* p, unsigned v) { return __hip_atomic_fetch_add(p, v, __ATOMIC_RELAXED, __HIP_MEMORY_SCOPE_AGENT); }
__device__ __forceinline__ unsigned xb_xcc_id() { return (unsigned)__builtin_amdgcn_s_getreg((3 << 11) | 20) & 0xFu; }
#define XB_SPIN(cond, bar) do { unsigned _sp = 0; while (cond) { __builtin_amdgcn_s_sleep(1); \
    if ((++_sp & 255u) == 0u) { if (xb_ld(&(bar)[XB_TMO])) break; if (_sp > XB_SPIN_CAP) { atomicAdd(&(bar)[XB_TMO], 1u); break; } } } } while (0)
struct XcdBarrier { unsigned* bar; unsigned x; volatile LAS unsigned* st; };
__device__ __forceinline__ XcdBarrier xcd_barrier_post(unsigned* bar, volatile LAS unsigned* st) {
    XcdBarrier b; b.bar = bar; b.x = xb_xcc_id(); b.st = st;
    if (threadIdx.x == 0) (void)xb_add(&bar[XB_XCNT(b.x)], 1u);
    return b;
}
__device__ __forceinline__ void xcd_barrier_complete(unsigned* bar, unsigned x, unsigned& nloc, unsigned& nx) {
    const unsigned G = gridDim.x * gridDim.y * gridDim.z;
    unsigned sum, cnt, mine, sp = 0u;
    for (;;) {
        sum = 0u; cnt = 0u; mine = 0u;
#pragma unroll
        for (unsigned j = 0; j < 16; ++j) { const unsigned c = xb_ld(&bar[XB_XCNT(j)]); sum += c; cnt += (c > 0u) ? 1u : 0u; mine = (j == x) ? c : mine; }
        if (sum == G) break;
        __builtin_amdgcn_s_sleep(1);
        if ((++sp & 255u) == 0u) { if (xb_ld(&bar[XB_TMO])) break; if (sp > XB_SPIN_CAP) { atomicAdd(&bar[XB_TMO], 1u); break; } }
    }
    nloc = mine > 0u ? mine : 1u; nx = cnt > 0u ? cnt : 1u;
}
__device__ __forceinline__ void xcd_barrier(unsigned* bar, unsigned x, volatile LAS unsigned* st) {
    asm volatile("s_waitcnt vmcnt(0)" ::: "memory");
    __syncthreads();
    if (threadIdx.x == 0) {
        __builtin_amdgcn_s_waitcnt(0);
        unsigned nloc = st[0], nx = st[1];
        if (nloc == 0u) { xcd_barrier_complete(bar, x, nloc, nx); st[0] = nloc; st[1] = nx; }
        const unsigned old = xb_add(&bar[XB_XSUB(x)], 1u);
        const unsigned gen = old / nloc;
        if (old + 1u == (gen + 1u) * nloc) {
            __builtin_amdgcn_fence(__ATOMIC_RELEASE, "agent");
            asm volatile("s_waitcnt vmcnt(0)" ::: "memory");
            const unsigned og = xb_add(&bar[XB_TOP], 1u);
            const unsigned tg = og / nx;
            if (og + 1u == (tg + 1u) * nx) xb_add(&bar[XB_TOPGEN], 1u);
            else XB_SPIN(xb_ld(&bar[XB_TOPGEN]) == tg, bar);
            __builtin_amdgcn_fence(__ATOMIC_ACQUIRE, "agent");
            xb_add(&bar[XB_XGEN(x)], 1u);
            asm volatile("s_waitcnt vmcnt(0)" ::: "memory");
        } else {
            XB_SPIN(xb_ld(&bar[XB_XGEN(x)]) == gen, bar);
            __builtin_amdgcn_fence(__ATOMIC_ACQUIRE, "agent");
            asm volatile("s_waitcnt vmcnt(0)" ::: "memory");
        }
    }
    __syncthreads();
}

__device__ __forceinline__ void run_phase(const Params& p0, const int ph, char* smem, const bool dup = false) {
  const Params& p = opaque_params(p0);
  const float* mod0 = p.mod;
  const float* mod1 = p.mod + 18 * 12288;
  char* hsm = smem + (tidx_opaque() >> 8) * HALF_LDS;
  switch (ph) {
    case 0:
      FOR_ITEMS(1536 + 5984 + 4608, it) {
        if (it < 1536) ada_item(p, it, (float*)hsm);
        else if (it < 1536 + 5984) conv_item(p, it - 1536, (float*)hsm);
        else cache_item(p, it - 1536 - 5984);
      }
      break;
    case 1: phase_normmod<true>(p, nullptr, p.norm_mix_w, p.modp, 0, 2048); break;
    case 2: {
      GemmArgs g{}; g.A = p.Abuf; g.lda = 2048; g.B = p.Wt_in_ab; g.K = 2048; g.ntn = 21; g.ntiles = 34 * 21;
      g.C = p.R1; g.ldc = ABN; g.nvalid = ABN;
      gemm_phase<EPI_F32, 0>(p, g, smem);
    } break;
    case 3:
      FOR_ITEMS(NTOK / 2, it) post_proj_item(p, it);
      break;
    case 4:
      FOR_ITEMS(2176 + 2304, it) {
        if (it < 2304) ssd_s1_item(p, it, (float*)hsm);
        else idx_item(p, it - 2304);
      }
      break;
    case 5:
      FOR_ITEMS(1024 + 2176, it) {
        if (it < 1024) { if (!dup) ssd_s2_item(p, it); }
        else topk_item(p, it - 1024);
      }
      break;
    case 6:
      FOR_ITEMS(2304, it) { ssd_s3_item(p, it, (float*)hsm); }
      if (gridDim.x == 256) {
        const int hb = tidx_opaque() >> 8;
        const int b = blockIdx.x, x = b & 7, w = (b >> 3) * 2 + hb;
        const int tbase = (x >> 2) * 4096 + (x & 1) * 2048, gg = (x >> 1) & 1;
        for (int k = 0; k < 8; ++k) attn_item(p, tbase + (w + 64 * k) * 4, gg, hsm);
        if (b < 128) { int it = b * 2 + hb; attn_item(p, 8192 + (it >> 1) * 4, it & 1, hsm); }
      } else {
        FOR_ITEMS(4352, it) attn_item(p, (it >> 1) * 4, it & 1, hsm);
      }
      break;
    case 7: phase_ssdnorm(p); break;
    case 8: {
      GemmArgs g{}; g.A = p.Abuf; g.lda = 2048; g.B = p.Wt_out_ab; g.K = 2048; g.ntn = 8; g.ntiles = 32 * 8;
      g.xin = nullptr; g.xout = p.xcur; g.gate = mod0 + 4096;
      gemm_phase<EPI_RESID, 2>(p, g, smem);
    } break;
    case 9: phase_normmod<false>(p, p.xcur, p.norm_ffn_w, mod0, 6144, 8192); break;
    case 10: {
      GemmArgs g{}; g.A = p.Abuf; g.lda = 2048; g.B = p.Wt_gu; g.K = 2048; g.ntn = 44; g.ntiles = 34 * 44;
      g.H = (u16*)p.R1;
      gemm_phase<EPI_SWIGLU, 0>(p, g, smem);
    } break;
    case 11: {
      GemmArgs g{}; g.A = (const u16*)p.R1; g.lda = FFN; g.B = p.Wt_down; g.K = FFN; g.ntn = 8; g.ntiles = 32 * 8;
      g.xin = p.xcur; g.xout = p.xcur; g.gate = mod0 + 10240;
      gemm_phase<EPI_RESID, 2>(p, g, smem);
    } break;
    case 12: phase_normmod<false>(p, p.xcur, p.norm_mix_w + 2048, mod1, 0, 2048); break;
    case 13: {
      GemmArgs g{}; g.A = p.Abuf; g.lda = 2048; g.B = p.Wt_in_c; g.K = 2048; g.ntn = 16; g.ntiles = 32 * 16;
      g.C = p.R1; g.ldc = 4096; g.nvalid = 4096;
      gemm_phase<EPI_F32, 2>(p, g, smem);
    } break;
    case 14:
      FOR_ITEMS(NTOK, it) lru_conv_item(p, it);
      break;
    case 15: {
      GemmArgs g{}; g.A = p.Abuf; g.lda = 2048; g.B = p.Wt_ax; g.K = 128; g.ntn = 32; g.ntiles = 34 * 32;
      gemm_phase<EPI_LRU, 1>(p, g, smem);
    } break;
    case 16:
      break;
    case 17:
      FOR_ITEMS(640, it) lru_scan_item(p, it);
      break;
    case 18: {
      GemmArgs g{}; g.A = p.Abuf; g.lda = 2048; g.B = p.Wt_out_c; g.K = 2048; g.ntn = 8; g.ntiles = 32 * 8;
      g.xin = p.xcur; g.xout = p.xcur; g.gate = mod1 + 4096;
      gemm_phase<EPI_RESID, 2>(p, g, smem);
    } break;
    case 19: phase_normmod<false>(p, p.xcur, p.norm_ffn_w + 2048, mod1, 6144, 8192); break;
    case 20: {
      GemmArgs g{}; g.A = p.Abuf; g.lda = 2048; g.B = p.Wt_gu + (size_t)11264 * 2048; g.K = 2048; g.ntn = 44; g.ntiles = 34 * 44;
      g.H = (u16*)p.R1;
      gemm_phase<EPI_SWIGLU, 0>(p, g, smem);
    } break;
    case 21: {
      GemmArgs g{}; g.A = (const u16*)p.R1; g.lda = FFN; g.B = p.Wt_down + (size_t)2048 * FFN; g.K = FFN; g.ntn = 8; g.ntiles = 32 * 8;
      g.xin = p.xcur; g.xout = p.out; g.gate = mod1 + 10240;
      gemm_phase<EPI_RESID, 2>(p, g, smem);
    } break;
    default: break;
  }
}

__device__ __forceinline__ void cnt_barrier(unsigned* ctr, unsigned target) {
  asm volatile("s_waitcnt vmcnt(0)" ::: "memory");
  __syncthreads();
  if (threadIdx.x == 0) {
    __builtin_amdgcn_fence(__ATOMIC_RELEASE, "agent");
    asm volatile("s_waitcnt vmcnt(0)" ::: "memory");
    __hip_atomic_fetch_add(ctr, 1u, __ATOMIC_RELAXED, __HIP_MEMORY_SCOPE_AGENT);
    unsigned sp = 0;
    while (__hip_atomic_load(ctr, __ATOMIC_RELAXED, __HIP_MEMORY_SCOPE_AGENT) < target) {
      __builtin_amdgcn_s_sleep(2);
      if (++sp > (1u << 22)) break;
    }
    __builtin_amdgcn_fence(__ATOMIC_ACQUIRE, "agent");
    asm volatile("s_waitcnt vmcnt(0)" ::: "memory");
  }
  __syncthreads();
}

#define PH(n) run_phase(p, n, smem); if ((DUP_MASK >> n) & 1) { XSYNC(); run_phase(p, n, smem, true); }
#define XSYNC() grid.sync()
#define PHS(n) PH(n) cnt_barrier(p.bar, (unsigned)(n) * gridDim.x)
#define PHT(n, t) PH(n) cnt_barrier(p.bar, (unsigned)(t) * gridDim.x)
__global__ void __launch_bounds__(512, 2) k_all(Params p) {
  __shared__ __attribute__((aligned(1024))) char smem[2 * HALF_LDS];
  cg::grid_group grid = cg::this_grid();
  if (blockIdx.x == 0 && threadIdx.x == 0) __hip_atomic_store(p.bar, 0u, __ATOMIC_RELAXED, __HIP_MEMORY_SCOPE_AGENT);
  PH(0);
  grid.sync();
  PHS(1); PHS(2); PHS(3); PHS(4); PHS(5); PHS(6); PHS(7); PHS(8); PHS(9); PHS(10);
  PHS(11); PHS(12); PHS(13); PHS(14); PHS(15);
  PHT(17, 16); PHT(18, 17); PHT(19, 18); PHT(20, 19); PH(21);
}

extern "C" void kernel_launch(void* const* d_in, const int* in_sizes, int n_in, void* d_out, int out_size,
                              void* d_ws, size_t ws_size, hipStream_t stream) {
  static int grid_blocks = 0;
  if (!grid_blocks) {
    int dev = 0, cus = 0, per_cu = 0;
    (void)hipGetDevice(&dev);
    (void)hipDeviceGetAttribute(&cus, hipDeviceAttributeMultiprocessorCount, dev);
    (void)hipOccupancyMaxActiveBlocksPerMultiprocessor(&per_cu, k_all, 512, 0);
    if (per_cu > 1) per_cu = 1;
    if (per_cu < 1) per_cu = 1;
    grid_blocks = cus * per_cu;
  }
  Params p{};
  const float** fin = (const float**)d_in;
  p.x_prompt = fin[0]; p.x_sample = fin[1]; p.cache_k = fin[2]; p.cache_v = fin[3]; p.cache_ki = fin[4];
  p.state_ssm = fin[5]; p.state_ssm_conv = fin[6]; p.state_lru = fin[7]; p.state_lru_conv = fin[8];
  p.c_prompt = fin[9]; p.c_sample = fin[10]; p.ada_w = fin[11]; p.ada_b = fin[12]; p.norm_mix_w = fin[13];
  p.norm_ffn_w = fin[14]; p.w_in_ab = fin[15]; p.q_norm_w = fin[16]; p.k_norm_w = fin[17]; p.ssd_conv_w = fin[18];
  p.ssd_conv_b = fin[19]; p.ssd_dt_bias = fin[20]; p.ssd_a_log = fin[21]; p.ssd_d = fin[22]; p.ssd_norm_w = fin[23];
  p.w_out_ab = fin[24]; p.w_in_c = fin[25]; p.lru_conv_w = fin[26]; p.lru_conv_b = fin[27]; p.lru_w_a = fin[28];
  p.lru_b_a = fin[29]; p.lru_w_x = fin[30]; p.lru_b_x = fin[31]; p.lru_lambda = fin[32]; p.w_out_c = fin[33];
  p.ffn_w_gate = fin[34]; p.ffn_w_up = fin[35]; p.ffn_w_down = fin[36];
  p.out = (float*)d_out;
  char* ws = (char*)d_ws;
  size_t off = 0;
  auto take = [&](size_t bytes) { size_t o = off; off += (bytes + 255) & ~(size_t)255; return ws + o; };
  p.Wt_in_ab = (u16*)take((size_t)5376 * 2048 * 2);
  p.Wt_out_ab = (u16*)take((size_t)2048 * 2048 * 2);
  p.Wt_gu = (u16*)take((size_t)2 * 11264 * 2048 * 2);
  p.Wt_down = (u16*)take((size_t)2 * 2048 * 5632 * 2);
  p.Wt_in_c = (u16*)take((size_t)4096 * 2048 * 2);
  p.Wt_ax = (u16*)take((size_t)16 * 256 * 128 * 2);
  p.Wt_out_c = (u16*)take((size_t)2048 * 2048 * 2);
  p.mod = (float*)take((size_t)2 * 18 * 12288 * 4);
  p.modp = (float*)take((size_t)4 * 2 * 18 * 12288 * 4);
  p.Abuf = (u16*)take((size_t)NTOK * 2048 * 2);
  p.R1 = (float*)take((size_t)NTOK * ABN * 4);
  p.R2 = (float*)take((size_t)NTOK * 4096 * 4);
  p.xcur = (float*)take((size_t)NTOK * 2048 * 4);
  p.qb = (u16*)take((size_t)NTOK * 1024 * 2);
  p.qib = (u16*)take((size_t)NTOK * 1024 * 2);
  p.wi = (float*)take((size_t)NTOK * 16 * 4);
  p.Kb = (u16*)take((size_t)25088 * 256 * 2);
  p.Vb = (u16*)take((size_t)25088 * 256 * 2);
  p.kib = (u16*)take((size_t)25088 * 64 * 2);
  p.xs = (float*)take((size_t)NTOK * 1024 * 4);
  p.bm = (float*)take((size_t)NTOK * 256 * 4);
  p.cm = (float*)take((size_t)NTOK * 256 * 4);
  p.dt = (float*)take((size_t)NTOK * 16 * 4);
  p.cumb = (float*)take((size_t)NTOK * 16 * 4);
  p.sel = (int*)take((size_t)NTOK * 256 * 4);
  p.aggA = (float*)take((size_t)64 * 2048 * 4);
  p.aggU = (float*)take((size_t)64 * 2048 * 4);
  p.bar = (unsigned*)take((size_t)XCD_BAR_WORDS * 4);
  if (off > ws_size) fprintf(stderr, "workspace too small: need %zu have %zu\n", off, ws_size);
  void* args[] = {&p};
  hipError_t e = hipLaunchCooperativeKernel((void*)k_all, dim3(grid_blocks), dim3(512), args, 0, stream);
  if (e != hipSuccess) fprintf(stderr, "cooperative launch failed: %s (grid %d)\n", hipGetErrorString(e), grid_blocks);
}
```
